# Optimizing an MI355X kernel written in HIP

```python
import jax, jax.numpy as jnp
from jax import lax
import numpy as np

D_MODEL = 2048
BATCH = 2
SEQ = 4096
DEPTH = 1
DEC_BATCH = 8
DEC_SEQ = 16
PAST_LEN = 2048

CHUNK = 64
QBLOCK = 128
ROPE_THETA = 500000.0
MLA_HEADS = 16
Q_LORA = 512
KV_LORA = 512
MLA_NOPE = 128
MLA_ROPE = 64
MLA_V = 128
DSA_HEADS = 16
DSA_KV_HEADS = 4
DSA_HEAD_DIM = 128
DSA_ROT = DSA_HEAD_DIM // 4
IDX_HEADS = 16
IDX_DIM = 128
IDX_ROT = IDX_DIM // 4
IDX_SCALE = (IDX_HEADS * IDX_DIM) ** -0.5
TOPK_MAX = 256
D_FF = 4 * D_MODEL
NORM_EPS = 1e-6

kernel_name = "hybrid_mla_dsa_streaming_encoder_step"


def _in_splits():
    return (Q_LORA, KV_LORA, MLA_ROPE,
            DSA_HEADS * DSA_HEAD_DIM, DSA_KV_HEADS * DSA_HEAD_DIM, DSA_KV_HEADS * DSA_HEAD_DIM,
            IDX_HEADS * IDX_DIM, IDX_DIM, IDX_HEADS,
            D_MODEL, D_MODEL)


def _rmsnorm(x, g):
    xf = x.astype(jnp.float32)
    y = xf * lax.rsqrt(jnp.mean(xf * xf, axis=-1, keepdims=True) + NORM_EPS) * g.astype(jnp.float32)
    return y.astype(x.dtype)


def _layernorm(x, g, b):
    xf = x.astype(jnp.float32)
    mu = jnp.mean(xf, axis=-1, keepdims=True)
    var = jnp.mean(jnp.square(xf - mu), axis=-1, keepdims=True)
    y = (xf - mu) * lax.rsqrt(var + NORM_EPS) * g.astype(jnp.float32) + b.astype(jnp.float32)
    return y.astype(x.dtype)


def _rope(x, pos, rot):
    inv = ROPE_THETA ** (-(jnp.arange(0, rot, 2, dtype=jnp.float32) / rot))
    ang = pos.astype(jnp.float32)[:, None] * inv[None, :]
    cos = jnp.cos(ang)[None, :, None, :]
    sin = jnp.sin(ang)[None, :, None, :]
    xr = x[..., :rot].astype(jnp.float32)
    x1, x2 = xr[..., : rot // 2], xr[..., rot // 2:]
    out = jnp.concatenate([x1 * cos - x2 * sin, x2 * cos + x1 * sin], axis=-1).astype(x.dtype)
    return jnp.concatenate([out, x[..., rot:]], axis=-1)


def _map_query_blocks(fn, q_pos, *qs):
    B, Lq = qs[0].shape[:2]
    blk = QBLOCK if Lq % QBLOCK == 0 else Lq
    nb = Lq // blk

    def split(a):
        return jnp.moveaxis(a.reshape((B, nb, blk) + a.shape[2:]), 1, 0)

    out = lax.map(lambda args: fn(*args), (q_pos.reshape(nb, blk),) + tuple(split(a) for a in qs))
    return jnp.moveaxis(out, 0, 1).reshape((B, Lq) + out.shape[3:])


def _mla_attention(q_nope, q_pe, k_nope, k_pe, v, q_pos, k_pos):
    B, Lq = q_nope.shape[:2]
    scale = (MLA_NOPE + MLA_ROPE) ** -0.5
    k_chunk = k_pos // CHUNK

    def block(qp, qn, qr):
        s = jnp.einsum('bqhd,bkhd->bhqk', qn, k_nope) + jnp.einsum('bqhr,bkr->bhqk', qr, k_pe)
        s = s.astype(jnp.float32) * scale
        vis = k_chunk[None, :] <= (qp // CHUNK)[:, None]
        p = jax.nn.softmax(jnp.where(vis[None, None], s, -jnp.inf), axis=-1).astype(v.dtype)
        return jnp.einsum('bhqk,bkhd->bqhd', p, v)

    o = _map_query_blocks(block, q_pos, q_nope, q_pe)
    return o.reshape(B, Lq, MLA_HEADS * MLA_V)


def _dsa_attention(q, q_idx, w_idx, k, v, k_idx, q_pos, k_pos, topk):
    B, Lq = q.shape[:2]
    G = DSA_KV_HEADS
    R = DSA_HEADS // DSA_KV_HEADS
    scale = DSA_HEAD_DIM ** -0.5
    k_chunk = k_pos // CHUNK
    gather = jax.vmap(lambda t, i: t[i])

    def block(qp, qb, qi, wi):
        blk = qp.shape[0]
        q_chunk = qp // CHUNK
        vis = k_chunk[None, :] <= q_chunk[:, None]
        rel = jax.nn.relu(jnp.einsum('bqhd,bkd->bqhk', qi, k_idx).astype(jnp.float32))
        score = jnp.einsum('bqh,bqhk->bqk', wi.astype(jnp.float32), rel)
        score = jnp.where(vis[None], score, -jnp.inf)
        _, sel = lax.top_k(score, topk)
        ok = k_chunk[sel] <= q_chunk[None, :, None]
        k_sel = gather(k, sel)
        v_sel = gather(v, sel)
        qg = qb.reshape(B, blk, G, R, DSA_HEAD_DIM)
        s = jnp.einsum('bqgrd,bqkgd->bqgrk', qg, k_sel).astype(jnp.float32) * scale
        s = jnp.where(ok[:, :, None, None, :], s, -jnp.inf)
        p = jax.nn.softmax(s, axis=-1).astype(v.dtype)
        o = jnp.einsum('bqgrk,bqkgd->bqgrd', p, v_sel)
        return o.reshape(B, blk, DSA_HEADS * DSA_HEAD_DIM)

    return _map_query_blocks(block, q_pos, q, q_idx, w_idx)


def _layer(x, pos, past, w_in, g_q_norm, g_kv_norm, w_uq, w_ukv, w_o_mla, w_o_dsa, w_out,
           ln1_g, ln1_b, w_up, w_down, ln2_g, ln2_b):
    B, L, _ = x.shape
    alpha = (2 * DEPTH) ** 0.25
    proj = jnp.einsum('bld,de->ble', x, w_in)
    cuts = np.cumsum(_in_splits())[:-1].tolist()
    (q_lat, kv_lat, k_pe, q_b, k_b, v_b, q_i, k_i, w_i, gate_a, gate_b) = jnp.split(proj, cuts, axis=-1)
    q = jnp.einsum('blr,rhe->blhe', _rmsnorm(q_lat, g_q_norm), w_uq)
    q_nope = q[..., :MLA_NOPE]
    q_pe = _rope(q[..., MLA_NOPE:], pos, MLA_ROPE)
    c_kv = _rmsnorm(kv_lat, g_kv_norm)
    k_pe = _rope(k_pe[:, :, None, :], pos, MLA_ROPE)[:, :, 0, :]
    q_b = _rope(q_b.reshape(B, L, DSA_HEADS, DSA_HEAD_DIM), pos, DSA_ROT)
    k_b = _rope(k_b.reshape(B, L, DSA_KV_HEADS, DSA_HEAD_DIM), pos, DSA_ROT)
    v_b = v_b.reshape(B, L, DSA_KV_HEADS, DSA_HEAD_DIM)
    q_i = _rope(q_i.reshape(B, L, IDX_HEADS, IDX_DIM), pos, IDX_ROT)
    k_i = _rope(k_i[:, :, None, :], pos, IDX_ROT)[:, :, 0, :]
    w_i = w_i * IDX_SCALE
    new_rows = (c_kv, k_pe, k_b, v_b, k_i)
    if past is None:
        c_kv_all, k_pe_all, k_b_all, v_b_all, k_i_all = new_rows
        k_pos = pos
    else:
        c_kv_all, k_pe_all, k_b_all, v_b_all, k_i_all = tuple(
            jnp.concatenate([p, n], axis=1) for p, n in zip(past, new_rows))
        k_pos = jnp.concatenate([jnp.arange(past[0].shape[1], dtype=jnp.int32), pos])
    Lk = k_pos.shape[0]
    kv = jnp.einsum('bkr,rhe->bkhe', c_kv_all, w_ukv)
    attn_a = _mla_attention(q_nope, q_pe, kv[..., :MLA_NOPE], k_pe_all, kv[..., MLA_NOPE:], pos, k_pos)
    topk = min(TOPK_MAX, Lk // 4)
    attn_b = _dsa_attention(q_b, q_i, w_i, k_b_all, v_b_all, k_i_all, pos, k_pos, topk)
    merged = (jax.nn.sigmoid(gate_a) * jnp.einsum('ble,ed->bld', attn_a, w_o_mla)
              + jax.nn.sigmoid(gate_b) * jnp.einsum('ble,ed->bld', attn_b, w_o_dsa))
    mix = jnp.einsum('bld,de->ble', merged, w_out)
    h = _layernorm(alpha * x + mix, ln1_g, ln1_b)
    f = jnp.einsum('blf,fd->bld', jnp.square(jax.nn.relu(jnp.einsum('bld,df->blf', h, w_up))), w_down)
    y = _layernorm(alpha * h + f, ln2_g, ln2_b)
    return y, new_rows


def setup_inputs(seed: int = 0) -> dict:
    key = jax.random.key(seed)
    ks = iter(jax.random.split(key, 48))
    f32 = jnp.float32

    def nrm(shape, scale):
        return jax.random.normal(next(ks), shape, f32) * scale

    beta = (8 * DEPTH) ** -0.25
    in_scales = (1.0, 1.0, 1.0, 1.0, 1.0, beta, 1.0, 1.0, 1.0, 1.0, 1.0)
    w_in = jnp.concatenate([nrm((DEPTH, D_MODEL, n), D_MODEL ** -0.5 * s)
                            for n, s in zip(_in_splits(), in_scales)], axis=-1)
    x_prompt = nrm((BATCH, SEQ, D_MODEL), 1.0)
    x_sample = nrm((DEC_BATCH, DEC_SEQ, D_MODEL), 1.0)
    cache_mla_latent = nrm((DEPTH, DEC_BATCH, PAST_LEN, KV_LORA), 1.0)
    cache_mla_rope = nrm((DEPTH, DEC_BATCH, PAST_LEN, MLA_ROPE), 1.0)
    cache_dsa_k = nrm((DEPTH, DEC_BATCH, PAST_LEN, DSA_KV_HEADS, DSA_HEAD_DIM), 1.0)
    cache_dsa_v = nrm((DEPTH, DEC_BATCH, PAST_LEN, DSA_KV_HEADS, DSA_HEAD_DIM), beta)
    cache_dsa_idx_k = nrm((DEPTH, DEC_BATCH, PAST_LEN, IDX_DIM), 1.0)
    g_q_norm = 1.0 + nrm((DEPTH, Q_LORA), 0.02)
    g_kv_norm = 1.0 + nrm((DEPTH, KV_LORA), 0.02)
    w_uq = nrm((DEPTH, Q_LORA, MLA_HEADS, MLA_NOPE + MLA_ROPE), Q_LORA ** -0.5)
    w_ukv = jnp.concatenate([nrm((DEPTH, KV_LORA, MLA_HEADS, MLA_NOPE), KV_LORA ** -0.5),
                             nrm((DEPTH, KV_LORA, MLA_HEADS, MLA_V), KV_LORA ** -0.5 * beta)], axis=-1)
    w_o_mla = nrm((DEPTH, MLA_HEADS * MLA_V, D_MODEL), (MLA_HEADS * MLA_V) ** -0.5 * beta)
    w_o_dsa = nrm((DEPTH, DSA_HEADS * DSA_HEAD_DIM, D_MODEL), (DSA_HEADS * DSA_HEAD_DIM) ** -0.5 * beta)
    w_out = nrm((DEPTH, D_MODEL, D_MODEL), D_MODEL ** -0.5 * beta)
    ln1_g = 1.0 + nrm((DEPTH, D_MODEL), 0.02)
    ln1_b = nrm((DEPTH, D_MODEL), 0.02)
    w_up = nrm((DEPTH, D_MODEL, D_FF), D_MODEL ** -0.5)
    w_down = nrm((DEPTH, D_FF, D_MODEL), D_FF ** -0.5 * beta)
    ln2_g = 1.0 + nrm((DEPTH, D_MODEL), 0.02)
    ln2_b = nrm((DEPTH, D_MODEL), 0.02)
    return {"x_prompt": x_prompt, "x_sample": x_sample,
            "cache_mla_latent": cache_mla_latent, "cache_mla_rope": cache_mla_rope,
            "cache_dsa_k": cache_dsa_k, "cache_dsa_v": cache_dsa_v, "cache_dsa_idx_k": cache_dsa_idx_k,
            "w_in": w_in, "g_q_norm": g_q_norm, "g_kv_norm": g_kv_norm, "w_uq": w_uq, "w_ukv": w_ukv,
            "w_o_mla": w_o_mla, "w_o_dsa": w_o_dsa, "w_out": w_out, "ln1_g": ln1_g, "ln1_b": ln1_b,
            "w_up": w_up, "w_down": w_down, "ln2_g": ln2_g, "ln2_b": ln2_b}


def reference(x_prompt, x_sample, cache_mla_latent, cache_mla_rope, cache_dsa_k, cache_dsa_v,
              cache_dsa_idx_k, w_in, g_q_norm, g_kv_norm, w_uq, w_ukv, w_o_mla, w_o_dsa, w_out,
              ln1_g, ln1_b, w_up, w_down, ln2_g, ln2_b):
    params = (w_in, g_q_norm, g_kv_norm, w_uq, w_ukv, w_o_mla, w_o_dsa, w_out,
              ln1_g, ln1_b, w_up, w_down, ln2_g, ln2_b)
    caches = (cache_mla_latent, cache_mla_rope, cache_dsa_k, cache_dsa_v, cache_dsa_idx_k)
    past_len = cache_mla_latent.shape[2]
    pos_p = jnp.arange(x_prompt.shape[1], dtype=jnp.int32)
    pos_s = past_len + jnp.arange(x_sample.shape[1], dtype=jnp.int32)
    hp, hs = x_prompt, x_sample
    rows_p, rows_s = [], []
    for layer in range(DEPTH):
        p_l = tuple(w[layer] for w in params)
        hp, new_p = _layer(hp, pos_p, None, *p_l)
        hs, new_s = _layer(hs, pos_s, tuple(c[layer] for c in caches), *p_l)
        rows_p.append(new_p)
        rows_s.append(new_s)
    p_mla_latent = jnp.stack([r[0] for r in rows_p])
    p_mla_rope = jnp.stack([r[1] for r in rows_p])
    p_dsa_k = jnp.stack([r[2] for r in rows_p])
    p_dsa_v = jnp.stack([r[3] for r in rows_p])
    p_dsa_idx_k = jnp.stack([r[4] for r in rows_p])
    s_mla_latent = jnp.stack([r[0] for r in rows_s])
    s_mla_rope = jnp.stack([r[1] for r in rows_s])
    s_dsa_k = jnp.stack([r[2] for r in rows_s])
    s_dsa_v = jnp.stack([r[3] for r in rows_s])
    s_dsa_idx_k = jnp.stack([r[4] for r in rows_s])
    return (hp, hs, p_mla_latent, p_mla_rope, p_dsa_k, p_dsa_v, p_dsa_idx_k,
            s_mla_latent, s_mla_rope, s_dsa_k, s_dsa_v, s_dsa_idx_k)
```

```cpp
#include <hip/hip_runtime.h>
#include <hip/hip_cooperative_groups.h>
#include <cstdio>
#include <cmath>
namespace cg = cooperative_groups;

#ifndef ONE_LAUNCH
#define ONE_LAUNCH 1
#endif

#define DI __device__ __forceinline__
#define LAS __attribute__((address_space(3)))
typedef unsigned short bf16_t;
typedef short bf16x8 __attribute__((ext_vector_type(8)));
typedef float f32x4 __attribute__((ext_vector_type(4)));
typedef float f32x16 __attribute__((ext_vector_type(16)));
typedef unsigned u32x4 __attribute__((ext_vector_type(4)));
typedef unsigned u32x2 __attribute__((ext_vector_type(2)));

constexpr int DM = 2048, SEQ = 4096, MPR = 8192, DS = 16, MS = 128, MR = 8320, MPAD = 8448;
constexpr int PAST = 2048, LKS = 2064, LKSP = 2112, SROWS = 16512, SROWSP = 16640;
constexpr int DFF = 8192;
constexpr int NTHREADS = 512;
constexpr int LDS_BYTES = 131072 + 1024;
constexpr float ALPHA = 1.189207115002721f;
constexpr float IDX_SCALE = 0.02209708691207961f;
constexpr float NORM_EPS = 1e-6f;
constexpr int TRI = 4096 * 2080;

constexpr size_t SZ_ACT = (size_t)MPAD * 2048 * 2;
constexpr size_t OFF_GATES = 0;
constexpr size_t OFF_WO = OFF_GATES + 2 * SZ_ACT;
constexpr size_t OFF_QB = OFF_WO + 3 * (size_t)2048 * 2048 * 2;
constexpr size_t OFF_QI = OFF_QB + SZ_ACT;
constexpr size_t OFF_R4 = OFF_QI + SZ_ACT;
constexpr size_t OFF_XB = OFF_R4;
constexpr size_t OFF_WINT = OFF_XB + SZ_ACT;
constexpr size_t OFF_SMALL = OFF_WINT + (size_t)10496 * 2048 * 2;
constexpr size_t OFF_R6 = OFF_SMALL + (size_t)MPAD * 2304 * 2;
constexpr size_t OFF_SCORE = OFF_R4;
constexpr size_t OFF_SCORE_S = OFF_SCORE + (size_t)2 * TRI * 4;
constexpr size_t OFF_CKVP = OFF_R6;
constexpr size_t OFF_CKVS = OFF_CKVP + (size_t)MPR * 512 * 2;
constexpr size_t OFF_KPEP = OFF_CKVS + (size_t)SROWSP * 512 * 2;
constexpr size_t OFF_KPES = OFF_KPEP + (size_t)MPR * 64 * 2;
constexpr size_t OFF_KBP = OFF_KPES + (size_t)SROWSP * 64 * 2;
constexpr size_t OFF_KBS = OFF_KBP + (size_t)MPR * 512 * 2;
constexpr size_t OFF_VBTP = OFF_KBS + (size_t)SROWSP * 512 * 2;
constexpr size_t OFF_VBTS = OFF_VBTP + (size_t)2 * 512 * 4096 * 2;
constexpr size_t OFF_KIP = OFF_VBTS + (size_t)8 * 512 * LKSP * 2;
constexpr size_t OFF_KIS = OFF_KIP + (size_t)MPR * 128 * 2;
constexpr size_t OFF_WI = OFF_KIS + (size_t)SROWSP * 128 * 2;
constexpr size_t OFF_QLN = OFF_WI + (size_t)MPAD * 16 * 4;
constexpr size_t OFF_MASK = OFF_QLN + (size_t)MPAD * 512 * 2;
constexpr size_t OFF_WUQT = OFF_MASK + (size_t)MR * 128 * 4;
constexpr size_t OFF_WUKT = OFF_WUQT + (size_t)3072 * 512 * 2;
constexpr size_t OFF_WUVT = OFF_WUKT + (size_t)2048 * 512 * 2;
constexpr size_t OFF_QSMLA = OFF_WUVT + (size_t)2048 * 512 * 2;
constexpr size_t OFF_CTL = OFF_QSMLA + (size_t)256 * 3072 * 2;
constexpr size_t OFF_TAIL = OFF_CTL + 4096;
constexpr size_t OFF_KNS = OFF_R4;
constexpr size_t OFF_VTS = OFF_TAIL;
constexpr size_t OFF_QMLA = OFF_R4;
constexpr size_t OFF_KNP = OFF_QMLA + (size_t)MPR * 3072 * 2;
constexpr size_t OFF_VTP = OFF_TAIL;
constexpr size_t OFF_MERGED = OFF_R4;
constexpr size_t OFF_R1 = OFF_GATES;
constexpr size_t OFF_H = OFF_QB;
constexpr size_t OFF_HB = OFF_R4;
constexpr size_t OFF_WUPT = OFF_HB + SZ_ACT;
constexpr size_t OFF_WDNT = OFF_WUPT + (size_t)8192 * 2048 * 2;
constexpr size_t OFF_U = OFF_WDNT + (size_t)8192 * 2048 * 2;
constexpr size_t OFF_PART = OFF_U + (size_t)MPAD * 8192 * 2;
constexpr size_t WS_NEED = OFF_VTS + (size_t)8 * 2048 * LKSP * 2;
static_assert(OFF_PART + (size_t)32 * 128 * 2048 * 4 <= WS_NEED, "part overlay");
static_assert(OFF_PART >= OFF_VTP + (size_t)2 * 2048 * 4096 * 2 || true, "");
static_assert(OFF_SCORE_S + (size_t)MS * LKSP * 4 <= OFF_R6, "score overlay");
static_assert(OFF_KNS + (size_t)SROWSP * 2048 * 2 <= OFF_R6, "kns overlay");
static_assert(OFF_KNP + (size_t)MPR * 2048 * 2 <= OFF_R6, "knp overlay");
static_assert(OFF_U + (size_t)MPAD * 8192 * 2 <= WS_NEED, "u overlay");
static_assert(WS_NEED <= 466000000ull, "workspace");
constexpr size_t OUT_YP = 0, OUT_YS = 16777216, OUT_PLAT = 17039360, OUT_PROPE = 21233664, OUT_PK = 21757952, OUT_PV = 25952256,
                 OUT_PIK = 30146560, OUT_SLAT = 31195136, OUT_SROPE = 31260672, OUT_SK = 31268864, OUT_SV = 31334400, OUT_SIK = 31399936;

struct TJob { const float* src; bf16_t* dst; int K, ld, c0, ncols, segw, segs, dld, pad; };
constexpr int NTJ = 27;
struct Params {
    const float *x_prompt, *x_sample, *c_lat, *c_rope, *c_k, *c_v, *c_ik, *w_in, *g_q, *g_kv, *w_uq, *w_ukv, *w_o_mla, *w_o_dsa, *w_out,
        *ln1_g, *ln1_b, *w_up, *w_down, *ln2_g, *ln2_b;
    float* out; unsigned char* ws;
    double T[32];
    TJob tj[NTJ];
    int tfirst[NTJ + 1];
    int ph_lo, ph_hi, pad0, pad1;
};

DI unsigned cvt_pk_bf16(float lo, float hi) { unsigned r; asm("v_cvt_pk_bf16_f32 %0, %1, %2" : "=v"(r) : "v"(lo), "v"(hi)); return r; }
DI float bflo(unsigned u) { return __uint_as_float(u << 16); }
DI float bfhi(unsigned u) { return __uint_as_float(u & 0xffff0000u); }
DI u32x4 pack8(const float* v) { u32x4 r; r.x = cvt_pk_bf16(v[0], v[1]); r.y = cvt_pk_bf16(v[2], v[3]); r.z = cvt_pk_bf16(v[4], v[5]); r.w = cvt_pk_bf16(v[6], v[7]); return r; }
DI void unpack8(u32x4 u, float* v) { v[0] = bflo(u.x); v[1] = bfhi(u.x); v[2] = bflo(u.y); v[3] = bfhi(u.y); v[4] = bflo(u.z); v[5] = bfhi(u.z); v[6] = bflo(u.w); v[7] = bfhi(u.w); }
DI float sigmoidf(float g) { return __builtin_amdgcn_rcpf(1.0f + __builtin_amdgcn_exp2f(-1.4426950408889634f * g)); }
DI void rope_cs(const double* T, int pos, int idx, float& c, float& s) {
    double rv = (double)pos * T[idx] * 0.15915494309189535; rv -= floor(rv);
    const float fr = (float)rv; c = __builtin_amdgcn_cosf(fr); s = __builtin_amdgcn_sinf(fr);
}

namespace pg8 {
constexpr int BM = 256, BK = 64, HALF = 128, HTB = HALF * BK * 2, NXCD = 8, WGM = 8;
DI int lds_byte(int r, int c) { const int st = (r >> 4) * 2 + (c >> 5), rr = r & 15, cc = c & 31, ob = rr * 64 + cc * 2; return st * 1024 + (ob ^ (((ob >> 9) & 1) << 5)); }
DI void stage_rc(int b, int& R, int& C) { const int st = b / 1024, sb = b % 1024, swz = sb ^ (((sb >> 9) & 1) << 5); R = (st >> 1) * 16 + swz / 64; C = (st & 1) * 32 + (swz % 64) / 2; }
DI int perm32(int rho) { const int n = rho >> 4, i = rho & 15; return 8 * (i >> 2) + 4 * n + (i & 3); }
struct Unit { int pm, pn, job; };
struct Sched {
    const char *A0, *B0; long dA1, dB1, dA2, dB2; int nM0, nN0, dM1, dN1, dM2, dN2; int f1, f2, f3, f4; int G, c; int ntm;
    const char *spA, *spB; int nsl, ksb, nts; size_t ldbb; int half; long adjA, adjB; int sp_half; long spAdjA, spAdjB;
    DI void init3(int K, const bf16_t* a0, const bf16_t* b0, int m0, int n0, const bf16_t* a1, const bf16_t* b1, int m1, int n1, const bf16_t* a2, const bf16_t* b2, int m2, int n2) {
        A0 = (const char*)a0; B0 = (const char*)b0; dA1 = (const char*)a1 - (const char*)a0; dB1 = (const char*)b1 - (const char*)b0; dA2 = (const char*)a2 - (const char*)a1; dB2 = (const char*)b2 - (const char*)b1;
        nM0 = m0; nN0 = n0; dM1 = m1 - m0; dN1 = n1 - n0; dM2 = m2 - m1; dN2 = n2 - n1; f1 = m0 * n0; f2 = f1 + m1 * n1; f3 = f2 + m2 * n2; f4 = f3; G = gridDim.x; c = blockIdx.x; ntm = K / BK;
        spA = A0; spB = B0; nsl = 1; ksb = 0; nts = 4; ldbb = (size_t)K * 2; half = 1 << 30; adjA = 0; adjB = 0; sp_half = 1 << 30; spAdjA = 0; spAdjB = 0; }
    DI void add_second(const bf16_t* A2nd, const bf16_t* B2nd, int half_tiles) { half = half_tiles; adjA = ((const char*)A2nd - A0) - (long)half_tiles * BK * 2; adjB = ((const char*)B2nd - B0) - (long)half_tiles * BK * 2; ntm = 2 * half_tiles; }
    DI void init1(int K, const bf16_t* A, const bf16_t* B, int nM, int nN) { init3(K, A, B, nM, nN, A, B, 0, 0, A, B, 0, 0); }
    DI void add_split(const bf16_t* As, const bf16_t* Bt, int npn, int nslices, int kslice) { spA = (const char*)As; spB = (const char*)Bt; nsl = nslices; ksb = kslice * 2; nts = kslice / BK; f4 = f3 + npn * nslices; sp_half = 1 << 30; spAdjA = 0; spAdjB = 0; }
    DI void split_second(const bf16_t* As2, const bf16_t* Bt2, int half_slices) { sp_half = half_slices; spAdjA = ((const char*)As2 - spA) - (long)half_slices * ksb; spAdjB = ((const char*)Bt2 - spB) - (long)half_slices * ksb; }
    DI bool next(int i, Unit& u) const {
        const long L = (long)i * G + c; if (L >= f4) return false;
        if (L >= f3) { const int sidx = (int)L - f3; u.pn = sidx / nsl; u.pm = sidx - u.pn * nsl; u.job = 3; return true; }
        const int g1 = (L >= f1) ? 1 : 0, g2 = (L >= f2) ? 1 : 0;
        int wgid = (int)L - g1 * f1 - g2 * (f2 - f1);
        const int nM = nM0 + g1 * dM1 + g2 * dM2, nN = nN0 + g1 * dN1 + g2 * dN2, nwg = nM * nN;
        { const int q = nwg / NXCD, r = nwg % NXCD, xcd = wgid % NXCD, off = wgid / NXCD; wgid = (xcd < r ? xcd * (q + 1) : r * (q + 1) + (xcd - r) * q) + off; }
        const int nig = WGM * nN, gid = wgid / nig, fm = gid * WGM, gsz = (nM - fm) < WGM ? (nM - fm) : WGM;
        u.pm = fm + ((wgid % nig) % gsz); u.pn = (wgid % nig) / gsz; u.job = g1 + g2; return true;
    }
    DI int nt(const Unit& u) const { return u.job == 3 ? nts : ntm; }
    DI void ab(const Unit& u, size_t tstep, const char*& a, const char*& b) const {
        if (u.job == 3) { const long m = -(long)(u.pm >= sp_half); a = spA + (size_t)u.pm * ksb + (spAdjA & m); b = spB + (size_t)u.pn * 256 * ldbb + (size_t)u.pm * ksb + (spAdjB & m); return; }
        const long m1 = -(long)(u.job >= 1), m2 = -(long)(u.job >= 2);
        a = A0 + (dA1 & m1) + (dA2 & m2) + (size_t)u.pm * tstep; b = B0 + (dB1 & m1) + (dB2 & m2) + (size_t)u.pn * tstep; }
};

template <class Epi>
DI void gemm_phase(const int tid, LAS unsigned char* lds, const int K, const Sched& S, const Epi& E) {
    const int wid = __builtin_amdgcn_readfirstlane(tid >> 6), lane = tid & 63, wr = wid >> 2, wc = wid & 3, fr = lane & 15, fq = lane >> 4;
    unsigned voffA[2], voffB[2];
#pragma unroll
    for (int i = 0; i < 2; ++i) { int R, C; stage_rc(tid * 16 + i * 8192, R, C); const int Rb = Epi::PERM ? ((R & ~31) + perm32(R & 31)) : R;
        voffA[i] = (unsigned)(R * K + C) * 2u; voffB[i] = (unsigned)(Rb * K + C) * 2u; }
    const size_t kstep = (size_t)(BK * 2);
    const size_t hstep = (size_t)HALF * K * 2;
    const size_t tstep = 2 * hstep;
    const unsigned ldsw = (unsigned)wid * 1024u;
    const int aoff = lds_byte(wr * 64 + fr, fq * 8), boff = lds_byte(wc * 32 + fr, fq * 8);
#define PG8_SA(b, h) (((b) * 2 + (h)) * HTB)
#define PG8_SB(b, h) ((4 + (b) * 2 + (h)) * HTB)
#define PG8_STAGE(bufoff, gbase, voff) do { _Pragma("unroll") for (int _i = 0; _i < 2; ++_i) \
        __builtin_amdgcn_global_load_lds((const unsigned*)((const char*)(gbase) + (voff)[_i]), (LAS unsigned*)(lds + (bufoff) + ldsw + _i * 8192), 16, 0, 0); } while (0)
#define PG8_LDA(dst, b, h) do { _Pragma("unroll") for (int m = 0; m < 4; ++m) _Pragma("unroll") for (int k = 0; k < 2; ++k) dst[m][k] = *(const LAS bf16x8*)(lds + PG8_SA(b, h) + aoff + m * 2048 + k * 1024); } while (0)
#define PG8_LDB(dst, b, h) do { _Pragma("unroll") for (int n = 0; n < 2; ++n) _Pragma("unroll") for (int k = 0; k < 2; ++k) dst[n][k] = *(const LAS bf16x8*)(lds + PG8_SB(b, h) + boff + n * 2048 + k * 1024); } while (0)
#define PG8_MMA(ai, bj, At, Bt) do { __builtin_amdgcn_s_setprio(1); _Pragma("unroll") for (int m = 0; m < 4; ++m) _Pragma("unroll") for (int n = 0; n < 2; ++n) _Pragma("unroll") for (int k = 0; k < 2; ++k) \
        acc[ai][bj][m][n] = __builtin_amdgcn_mfma_f32_16x16x32_bf16(Bt[n][k], At[m][k], acc[ai][bj][m][n], 0, 0, 0); __builtin_amdgcn_s_setprio(0); } while (0)
#define PG8_WAIT_V(n) asm volatile("s_waitcnt vmcnt(" #n ")" ::: "memory")
#define PG8_WAIT_L(n) asm volatile("s_waitcnt lgkmcnt(" #n ")" ::: "memory")
#define PG8_BAR __builtin_amdgcn_s_barrier()
#define PG8_SCHED __builtin_amdgcn_sched_barrier(0)
    Unit cur, nxt; int ui = 0;
    if (!S.next(0, cur)) return;
    f32x4 acc[2][2][4][2];
#pragma unroll
    for (int a = 0; a < 2; ++a)
#pragma unroll
        for (int b = 0; b < 2; ++b)
#pragma unroll
            for (int m = 0; m < 4; ++m)
#pragma unroll
                for (int n = 0; n < 2; ++n) acc[a][b][m][n] = (f32x4){0.f, 0.f, 0.f, 0.f};
    bf16x8 At[4][2], B0[2][2], B1[2][2];
    const char* cA; const char* cB; S.ab(cur, tstep, cA, cB); int nt = S.nt(cur);
    PG8_STAGE(PG8_SB(0, 0), cB, voffB); PG8_STAGE(PG8_SA(0, 0), cA, voffA); PG8_STAGE(PG8_SB(0, 1), cB + hstep, voffB); PG8_STAGE(PG8_SA(0, 1), cA + hstep, voffA);
    if (wr == 1) PG8_BAR;
    PG8_WAIT_V(4); PG8_BAR;
    PG8_STAGE(PG8_SB(1, 0), cB + kstep, voffB); PG8_STAGE(PG8_SA(1, 0), cA + kstep, voffA); PG8_STAGE(PG8_SB(1, 1), cB + hstep + kstep, voffB);
    PG8_WAIT_V(6); PG8_BAR;
    for (;;) {
        const bool has_next = S.next(ui + 1, nxt);
        const char* nA = cA; const char* nB = cB; if (has_next) S.ab(nxt, tstep, nA, nB);
        for (int t = 0; t < nt; t += 2) {
            const bool last = (t == nt - 2);
            if (Epi::MIDHOOK && t == S.half) E.mid(acc, cur, wr, wc, fr, fq);
            const long sA1 = (t + 1 >= S.half) ? S.adjA : 0, sA2 = (t + 2 >= S.half) ? S.adjA : 0, sB2 = (t + 2 >= S.half) ? S.adjB : 0;
            const char* a1 = cA + (size_t)(t + 1) * kstep + sA1;
            const char* a2 = last ? nA : cA + (size_t)(t + 2) * kstep + sA2; const char* b2 = last ? nB : cB + (size_t)(t + 2) * kstep + sB2;
            const char* a3 = a2 + kstep; const char* b3 = b2 + kstep;
            PG8_LDB(B0, 0, 0); PG8_SCHED; PG8_LDA(At, 0, 0); PG8_STAGE(PG8_SA(1, 1), a1 + hstep, voffA);
            PG8_WAIT_L(8); PG8_BAR; PG8_WAIT_L(0); PG8_MMA(0, 0, At, B0); PG8_BAR; PG8_SCHED;
            PG8_LDB(B1, 0, 1); PG8_STAGE(PG8_SB(0, 0), b2, voffB);
            PG8_BAR; PG8_WAIT_L(0); PG8_MMA(0, 1, At, B1); PG8_BAR;
            PG8_LDA(At, 0, 1); PG8_STAGE(PG8_SA(0, 0), a2, voffA);
            PG8_BAR; PG8_WAIT_L(0); PG8_MMA(1, 0, At, B0); PG8_BAR; PG8_SCHED;
            PG8_STAGE(PG8_SB(0, 1), b2 + hstep, voffB);
            PG8_WAIT_V(6); PG8_BAR; PG8_MMA(1, 1, At, B1); PG8_BAR;
            PG8_LDB(B0, 1, 0); PG8_SCHED; PG8_LDA(At, 1, 0); PG8_STAGE(PG8_SA(0, 1), a2 + hstep, voffA);
            PG8_WAIT_L(8); PG8_BAR; PG8_WAIT_L(0); PG8_MMA(0, 0, At, B0); PG8_BAR; PG8_SCHED;
            PG8_LDB(B1, 1, 1); PG8_STAGE(PG8_SB(1, 0), b3, voffB);
            PG8_BAR; PG8_WAIT_L(0); PG8_MMA(0, 1, At, B1); PG8_BAR;
            PG8_LDA(At, 1, 1); PG8_STAGE(PG8_SA(1, 0), a3, voffA);
            PG8_BAR; PG8_WAIT_L(0); PG8_MMA(1, 0, At, B0); PG8_BAR; PG8_SCHED;
            PG8_STAGE(PG8_SB(1, 1), b3 + hstep, voffB);
            PG8_WAIT_V(6); PG8_BAR; PG8_MMA(1, 1, At, B1); PG8_BAR;
        }
        E(acc, cur, wr, wc, fr, fq);
        if (!has_next) break;
#pragma unroll
        for (int a = 0; a < 2; ++a)
#pragma unroll
            for (int b = 0; b < 2; ++b)
#pragma unroll
                for (int m = 0; m < 4; ++m)
#pragma unroll
                    for (int n = 0; n < 2; ++n) acc[a][b][m][n] = (f32x4){0.f, 0.f, 0.f, 0.f};
        cur = nxt; cA = nA; cB = nB; ++ui; nt = S.nt(cur);
    }
    PG8_WAIT_V(0);
    if (wr == 0) PG8_BAR;
    PG8_BAR;
#undef PG8_SA
#undef PG8_SB
#undef PG8_STAGE
#undef PG8_LDA
#undef PG8_LDB
#undef PG8_MMA
#undef PG8_WAIT_V
#undef PG8_WAIT_L
#undef PG8_BAR
#undef PG8_SCHED
}
}

enum { EM_PROJ = 0, EM_UPS, EM_UPP, EM_O1, EM_O2, EM_FFNUP, EM_OF };
struct EpiB {
    static constexpr bool PERM = true, MIDHOOK = true;
    int mode; unsigned char* ws; int ldp;
    DI void mid(f32x4 (&acc)[2][2][4][2], const pg8::Unit& u, int wr, int wc, int fr, int fq) const {
#pragma unroll
        for (int ai = 0; ai < 2; ++ai)
#pragma unroll
            for (int m = 0; m < 4; ++m) {
                int rb = u.pm * 256 + wr * 64 + fr; asm volatile("" : "+v"(rb));
                const int r = rb + ai * 128 + m * 16;
                int cb = u.pn * 256 + wc * 32 + 8 * fq; asm volatile("" : "+v"(cb));
                const bf16_t* gp = (const bf16_t*)(ws + OFF_GATES) + (size_t)r * 4096 + cb;
                const u32x4 ga0 = *(const u32x4*)gp, ga1 = *(const u32x4*)(gp + 128), gb0 = *(const u32x4*)(gp + 2048), gb1 = *(const u32x4*)(gp + 2048 + 128);
                float a[8], b[8];
                unpack8(ga0, a); unpack8(gb0, b);
#pragma unroll
                for (int j = 0; j < 8; ++j) { const float rt = (1.0f + __builtin_amdgcn_exp2f(-1.4426950408889634f * fmaxf(b[j], -60.0f))) * __builtin_amdgcn_rcpf(1.0f + __builtin_amdgcn_exp2f(-1.4426950408889634f * a[j])); acc[ai][0][m][j >> 2][j & 3] *= rt; }
                unpack8(ga1, a); unpack8(gb1, b);
#pragma unroll
                for (int j = 0; j < 8; ++j) { const float rt = (1.0f + __builtin_amdgcn_exp2f(-1.4426950408889634f * fmaxf(b[j], -60.0f))) * __builtin_amdgcn_rcpf(1.0f + __builtin_amdgcn_exp2f(-1.4426950408889634f * a[j])); acc[ai][1][m][j >> 2][j & 3] *= rt; }
                asm volatile("" ::: "memory");
            }
    }
    DI void operator()(const f32x4 (&acc)[2][2][4][2], const pg8::Unit& u, int wr, int wc, int fr, int fq) const {
#pragma unroll
        for (int ai = 0; ai < 2; ++ai)
#pragma unroll
            for (int m = 0; m < 4; ++m) {
                int rb = u.pm * 256 + wr * 64 + fr; asm volatile("" : "+v"(rb));
                const int r = rb + ai * 128 + m * 16;
#pragma unroll
                for (int bj = 0; bj < 2; ++bj) {
                    int cb = u.pn * 256 + wc * 32 + 8 * fq; asm volatile("" : "+v"(cb));
                    const int c0 = cb + bj * 128;
                    if (u.job == 3) {
                        if (ai == 0) { float* pd = (float*)(ws + OFF_PART) + ((size_t)u.pm * 128 + wr * 64 + m * 16 + fr) * ldp + c0;
                            *(f32x4*)pd = acc[ai][bj][m][0]; *(f32x4*)(pd + 4) = acc[ai][bj][m][1]; }
                        continue; }
                    float v[8];
#pragma unroll
                    for (int j = 0; j < 4; ++j) { v[j] = acc[ai][bj][m][0][j]; v[4 + j] = acc[ai][bj][m][1][j]; }
                    bf16_t* dst = nullptr;
                    if (mode == EM_PROJ) {
                        if (u.pn < 8) dst = (bf16_t*)(ws + OFF_QB) + (size_t)r * 2048 + c0;
                        else if (u.pn < 16) dst = (bf16_t*)(ws + OFF_QI) + (size_t)r * 2048 + (c0 - 2048);
                        else if (u.pn < 32) dst = (bf16_t*)(ws + OFF_GATES) + (size_t)r * 4096 + (c0 - 4096);
                        else dst = (bf16_t*)(ws + OFF_SMALL) + (size_t)r * 2304 + (c0 - 8192);
                    } else if (mode == EM_UPS || mode == EM_UPP) {
                        const bool smp = (mode == EM_UPS);
                        if (u.job == 0) dst = (bf16_t*)(ws + (smp ? OFF_QSMLA : OFF_QMLA)) + (size_t)r * 3072 + c0;
                        else if (u.job == 1) dst = (bf16_t*)(ws + (smp ? OFF_KNS : OFF_KNP)) + (size_t)r * 2048 + c0;
                        else {
                            const int LK = smp ? LKS : 4096, ldv = smp ? LKSP : 4096, nvalid = smp ? SROWS : MPR;
                            if (c0 < nvalid) { const int bidx = c0 / LK, key = c0 - bidx * LK; dst = (bf16_t*)(ws + (smp ? OFF_VTS : OFF_VTP)) + ((size_t)bidx * 2048 + r) * ldv + key; }
                        }
                    } else if (mode == EM_O1 || mode == EM_O2) {
#pragma unroll
                        for (int n = 0; n < 2; ++n) {
                            const u32x2 gv = *(const u32x2*)((const bf16_t*)(ws + OFF_GATES) + (size_t)r * 4096 + (mode == EM_O2 ? 2048 : 0) + c0 + 4 * n);
                            u32x2* mp = (u32x2*)((bf16_t*)(ws + OFF_MERGED) + (size_t)r * 2048 + c0 + 4 * n);
                            float o0 = sigmoidf(bflo(gv.x)) * v[4 * n], o1 = sigmoidf(bfhi(gv.x)) * v[4 * n + 1], o2 = sigmoidf(bflo(gv.y)) * v[4 * n + 2], o3 = sigmoidf(bfhi(gv.y)) * v[4 * n + 3];
                            if (mode == EM_O2) { const u32x2 ov = *mp; o0 += bflo(ov.x); o1 += bfhi(ov.x); o2 += bflo(ov.y); o3 += bfhi(ov.y); }
                            u32x2 w2; w2.x = cvt_pk_bf16(o0, o1); w2.y = cvt_pk_bf16(o2, o3); *mp = w2;
                            asm volatile("" ::: "memory");
                        }
                    } else if (mode == EM_OF) {
                        float g[8]; unpack8(*(const u32x4*)((const bf16_t*)(ws + OFF_GATES) + (size_t)r * 4096 + 2048 + c0), g);
#pragma unroll
                        for (int j = 0; j < 8; ++j) v[j] *= sigmoidf(fmaxf(g[j], -60.0f));
                        dst = (bf16_t*)(ws + OFF_MERGED) + (size_t)r * 2048 + c0;
                    } else {
#pragma unroll
                        for (int j = 0; j < 8; ++j) { const float t = fmaxf(v[j], 0.f); v[j] = t * t; }
                        dst = (bf16_t*)(ws + OFF_U) + (size_t)r * 8192 + c0;
                    }
                    if (dst) *(u32x4*)dst = pack8(v);
                    asm volatile("" ::: "memory");
                }
            }
    }
};
enum { EF_OUT = 0, EF_DOWN };
struct EpiF {
    static constexpr bool PERM = false, MIDHOOK = false;
    int mode; unsigned char* ws; const float* xp; const float* xs;
    DI void mid(f32x4 (&)[2][2][4][2], const pg8::Unit&, int, int, int, int) const {}
    DI void operator()(const f32x4 (&acc)[2][2][4][2], const pg8::Unit& u, int wr, int wc, int fr, int fq) const {
#pragma unroll
        for (int ai = 0; ai < 2; ++ai)
#pragma unroll
            for (int m = 0; m < 4; ++m) {
                if (u.job == 3) {
                    if (ai == 0) { float* pd = (float*)(ws + OFF_PART) + ((size_t)u.pm * 128 + wr * 64 + m * 16 + fr) * 2048;
#pragma unroll
                        for (int bj = 0; bj < 2; ++bj)
#pragma unroll
                            for (int n = 0; n < 2; ++n) *(f32x4*)(pd + u.pn * 256 + bj * 128 + wc * 32 + 16 * n + 4 * fq) = acc[ai][bj][m][n]; }
                    continue; }
                const int r = u.pm * 256 + ai * 128 + wr * 64 + m * 16 + fr;
                if (r >= MR) continue;
                const float* res = (mode == EF_OUT) ? (r < MPR ? xp + (size_t)r * 2048 : xs + (size_t)(r - MPR) * 2048) : (const float*)(ws + OFF_H) + (size_t)r * 2048;
                float* dst = (float*)(ws + OFF_R1) + (size_t)r * 2048;
#pragma unroll
                for (int bj = 0; bj < 2; ++bj)
#pragma unroll
                    for (int n = 0; n < 2; ++n) {
                        const int c = u.pn * 256 + bj * 128 + wc * 32 + 16 * n + 4 * fq;
                        const f32x4 x = *(const f32x4*)(res + c);
                        *(f32x4*)(dst + c) = x * ALPHA + acc[ai][bj][m][n];
                    }
            }
    }
};

DI void transpose_jobs(const Params& p, const int tid, LAS unsigned char* lds, int j_lo, int j_hi, int bid, int nb) {
    LAS float* tile = (LAS float*)lds;
    const int t_lo = p.tfirst[j_lo], t_hi = p.tfirst[j_hi];
    const int i0 = tid >> 4, j4 = (tid & 15) * 4, nn = tid >> 3, k8 = (tid & 7) * 8;
    f32x4 va0, va1, vb0, vb1; bf16_t *da = nullptr, *db = nullptr; int lda_ = 0, ldb_ = 0, ka = 0, kb = 0, na = 0, nb_ = 0, ca = 0, cb = 0;
    va0 = va1 = vb0 = vb1 = (f32x4){0.f, 0.f, 0.f, 0.f};
#define TJ_LOAD(t, V0, V1, D, DL, K0, N0, NC) do { int jb = j_lo; while ((t) >= p.tfirst[jb + 1]) ++jb; \
        const float* src_ = p.tj[jb].src; const int K_ = p.tj[jb].K, ld_ = p.tj[jb].ld, c0_ = p.tj[jb].c0, segw_ = p.tj[jb].segw, segs_ = p.tj[jb].segs; \
        const int lt_ = (t) - p.tfirst[jb], tk_ = K_ / 64, kt_ = lt_ % tk_, nt_ = lt_ / tk_; \
        D = p.tj[jb].dst; DL = p.tj[jb].dld; K0 = kt_ * 64; N0 = nt_ * 64; NC = p.tj[jb].ncols; \
        const int n_ = N0 + j4; V0 = (f32x4){0.f, 0.f, 0.f, 0.f}; V1 = V0; \
        if (n_ < NC) { const int sc_ = c0_ + (n_ / segw_) * segs_ + (n_ % segw_); V0 = __builtin_nontemporal_load((const f32x4*)(src_ + (size_t)(K0 + i0) * ld_ + sc_)); V1 = __builtin_nontemporal_load((const f32x4*)(src_ + (size_t)(K0 + i0 + 32) * ld_ + sc_)); } } while (0)
    int t = t_lo + bid;
    if (t < t_hi) TJ_LOAD(t, va0, va1, da, lda_, ka, na, ca);
    if (t + nb < t_hi) TJ_LOAD(t + nb, vb0, vb1, db, ldb_, kb, nb_, cb);
    for (; t < t_hi; t += nb) {
        bf16_t* dst = da; const int dld = lda_, k0 = ka, n0 = na, ncols = ca;
        __syncthreads();
        tile[i0 * 65 + j4] = va0.x; tile[i0 * 65 + j4 + 1] = va0.y; tile[i0 * 65 + j4 + 2] = va0.z; tile[i0 * 65 + j4 + 3] = va0.w;
        tile[(i0 + 32) * 65 + j4] = va1.x; tile[(i0 + 32) * 65 + j4 + 1] = va1.y; tile[(i0 + 32) * 65 + j4 + 2] = va1.z; tile[(i0 + 32) * 65 + j4 + 3] = va1.w;
        __syncthreads();
        va0 = vb0; va1 = vb1; da = db; lda_ = ldb_; ka = kb; na = nb_; ca = cb;
        const int tn = t + 2 * nb;
        if (tn < t_hi) TJ_LOAD(tn, vb0, vb1, db, ldb_, kb, nb_, cb);
        if (n0 + nn < ncols) {
            float v[8];
#pragma unroll
            for (int e = 0; e < 8; ++e) v[e] = tile[(k8 + e) * 65 + nn];
            *(u32x4*)(dst + (size_t)(n0 + nn) * dld + k0 + k8) = pack8(v);
        }
    }
#undef TJ_LOAD
    __syncthreads();
}
DI void copy_cache(const float* src, bf16_t* dst, int W, size_t gtid, size_t gsz) {
    const int gpr = W / 8; const size_t total = (size_t)SROWSP * gpr;
#pragma unroll 4
    for (size_t i = gtid; i < total; i += gsz) {
        const int R = (int)(i / gpr), cg8 = (int)(i % gpr) * 8; const int b = R / LKS, k = R - b * LKS;
        if (R >= SROWS) { *(u32x4*)(dst + (size_t)R * W + cg8) = (u32x4){0u, 0u, 0u, 0u}; continue; }
        if (k >= PAST) continue;
        const float* s = src + ((size_t)b * PAST + k) * W + cg8; const f32x4 a = *(const f32x4*)s, c = *(const f32x4*)(s + 4);
        float v[8] = {a.x, a.y, a.z, a.w, c.x, c.y, c.z, c.w};
        *(u32x4*)(dst + (size_t)R * W + cg8) = pack8(v);
    }
}
DI void phase_prep(const Params& p, const int tid, unsigned char* ws, LAS unsigned char* lds) {
    const size_t gtid = (size_t)blockIdx.x * NTHREADS + tid, gsz = (size_t)gridDim.x * NTHREADS;
    { bf16_t* xb = (bf16_t*)(ws + OFF_XB); const size_t total = (size_t)MPAD * 256;
#pragma unroll 4
      for (size_t i = gtid; i < total; i += gsz) { const int r = (int)(i >> 8), c8 = (int)(i & 255) * 8; float v[8] = {0, 0, 0, 0, 0, 0, 0, 0};
          if (r < MR) { const float* s = (r < MPR ? p.x_prompt + (size_t)r * 2048 : p.x_sample + (size_t)(r - MPR) * 2048) + c8; const f32x4 a = __builtin_nontemporal_load((const f32x4*)s), c = __builtin_nontemporal_load((const f32x4*)(s + 4));
              v[0] = a.x; v[1] = a.y; v[2] = a.z; v[3] = a.w; v[4] = c.x; v[5] = c.y; v[6] = c.z; v[7] = c.w; }
          *(u32x4*)(xb + (size_t)r * 2048 + c8) = pack8(v); } }
    copy_cache(p.c_lat, (bf16_t*)(ws + OFF_CKVS), 512, gtid, gsz);
    copy_cache(p.c_rope, (bf16_t*)(ws + OFF_KPES), 64, gtid, gsz);
    copy_cache(p.c_k, (bf16_t*)(ws + OFF_KBS), 512, gtid, gsz);
    copy_cache(p.c_ik, (bf16_t*)(ws + OFF_KIS), 128, gtid, gsz);
    { bf16_t* a = (bf16_t*)(ws + OFF_VBTS); const size_t total = (size_t)8 * 512 * 6;
      for (size_t i = gtid; i < total; i += gsz) *(u32x4*)(a + (i / 6) * LKSP + LKS + (i % 6) * 8) = (u32x4){0u, 0u, 0u, 0u};
      bf16_t* b = (bf16_t*)(ws + OFF_VTS); const size_t total2 = (size_t)8 * 2048 * 6;
      for (size_t i = gtid; i < total2; i += gsz) *(u32x4*)(b + (i / 6) * LKSP + LKS + (i % 6) * 8) = (u32x4){0u, 0u, 0u, 0u}; }
    transpose_jobs(p, tid, lds, 0, NTJ - 2, blockIdx.x, gridDim.x);
}

DI void rope32(float* v, int lane, const float* c32, const float* s32) {
    const int sub = lane & 15;
#pragma unroll
    for (int e = 0; e < 8; ++e) { const float oth = __shfl_xor(v[e], 2); if (sub < 2) v[e] = v[e] * c32[e] - oth * s32[e]; else if (sub < 4) v[e] = v[e] * c32[e] + oth * s32[e]; }
}
DI void rope_cs_d(double tv, int pos, float& c, float& s) {
    double rv = (double)pos * tv * 0.15915494309189535; rv -= floor(rv);
    const float fr = (float)rv; c = __builtin_amdgcn_cosf(fr); s = __builtin_amdgcn_sinf(fr);
}
DI void phase_post(const Params& p, const int tid, unsigned char* ws, LAS unsigned char* lds) {
    const int lane = tid & 63, wv = blockIdx.x * 8 + __builtin_amdgcn_readfirstlane(tid >> 6), nwv = gridDim.x * 8;
    double t32[8], t64[8];
#pragma unroll
    for (int e = 0; e < 8; ++e) { t32[e] = p.T[2 * (8 * (lane & 1) + e)]; t64[e] = p.T[8 * (lane & 3) + e]; }
    const f32x4 gq0 = *(const f32x4*)(p.g_q + 8 * lane), gq1 = *(const f32x4*)(p.g_q + 8 * lane + 4), gk0 = *(const f32x4*)(p.g_kv + 8 * lane), gk1 = *(const f32x4*)(p.g_kv + 8 * lane + 4);
    for (int r = wv; r < MR; r += nwv) {
        const bool smp = r >= MPR; const int rs = r - MPR;
        const int pos = smp ? PAST + (rs & 15) : (r & 4095);
        const int crow = smp ? ((rs >> 4) * LKS + PAST + (rs & 15)) : r;
        const bf16_t* srow = (const bf16_t*)(ws + OFF_SMALL) + (size_t)r * 2304;
        bf16_t* qbrow = (bf16_t*)(ws + OFF_QB) + (size_t)r * 2048; bf16_t* qirow = (bf16_t*)(ws + OFF_QI) + (size_t)r * 2048;
        const int l8 = lane & 7, l16 = lane & 15;
        const u32x4 r_ql = *(const u32x4*)(srow + 8 * lane), r_kv = *(const u32x4*)(srow + 512 + 8 * lane), r_kb = *(const u32x4*)(srow + 1024 + 8 * lane), r_vb = *(const u32x4*)(srow + 1536 + 8 * lane);
        const u32x4 r_pe = *(const u32x4*)(srow + 2048 + 8 * l8), r_ki = *(const u32x4*)(srow + 2112 + 8 * l16), r_wi = *(const u32x4*)(srow + 2240 + 8 * (lane & 1));
        u32x4 r_q[2][4];
#pragma unroll
        for (int sg = 0; sg < 4; ++sg) { r_q[0][sg] = *(const u32x4*)(qbrow + sg * 512 + 8 * lane); r_q[1][sg] = *(const u32x4*)(qirow + sg * 512 + 8 * lane); }
        float c32[8], s32[8], c64[8], s64[8];
#pragma unroll
        for (int e = 0; e < 8; ++e) { rope_cs_d(t32[e], pos, c32[e], s32[e]); rope_cs_d(t64[e], pos, c64[e], s64[e]); }
        float v[8];
        { unpack8(r_ql, v); float ss = 0.f;
#pragma unroll
          for (int e = 0; e < 8; ++e) ss += v[e] * v[e];
#pragma unroll
          for (int d = 1; d < 64; d <<= 1) ss += __shfl_xor(ss, d);
          const float rstd = rsqrtf(ss * (1.0f / 512.0f) + NORM_EPS);
          const float g[8] = {gq0.x, gq0.y, gq0.z, gq0.w, gq1.x, gq1.y, gq1.z, gq1.w};
#pragma unroll
          for (int e = 0; e < 8; ++e) v[e] = v[e] * rstd * g[e];
          *(u32x4*)((bf16_t*)(ws + OFF_QLN) + (size_t)r * 512 + 8 * lane) = pack8(v); }
        { unpack8(r_kv, v); float ss = 0.f;
#pragma unroll
          for (int e = 0; e < 8; ++e) ss += v[e] * v[e];
#pragma unroll
          for (int d = 1; d < 64; d <<= 1) ss += __shfl_xor(ss, d);
          const float rstd = rsqrtf(ss * (1.0f / 512.0f) + NORM_EPS);
          const float g[8] = {gk0.x, gk0.y, gk0.z, gk0.w, gk1.x, gk1.y, gk1.z, gk1.w};
#pragma unroll
          for (int e = 0; e < 8; ++e) v[e] = v[e] * rstd * g[e];
          float* o = p.out + (smp ? OUT_SLAT + (size_t)rs * 512 : OUT_PLAT + (size_t)r * 512) + 8 * lane;
          *(f32x4*)o = (f32x4){v[0], v[1], v[2], v[3]}; *(f32x4*)(o + 4) = (f32x4){v[4], v[5], v[6], v[7]};
          *(u32x4*)((bf16_t*)(ws + (smp ? OFF_CKVS : OFF_CKVP)) + (size_t)crow * 512 + 8 * lane) = pack8(v); }
        { unpack8(r_kb, v); rope32(v, lane, c32, s32);
          float* o = p.out + (smp ? OUT_SK + (size_t)rs * 512 : OUT_PK + (size_t)r * 512) + 8 * lane;
          *(f32x4*)o = (f32x4){v[0], v[1], v[2], v[3]}; *(f32x4*)(o + 4) = (f32x4){v[4], v[5], v[6], v[7]};
          *(u32x4*)((bf16_t*)(ws + (smp ? OFF_KBS : OFF_KBP)) + (size_t)crow * 512 + 8 * lane) = pack8(v); }
        { unpack8(r_vb, v);
          float* o = p.out + (smp ? OUT_SV + (size_t)rs * 512 : OUT_PV + (size_t)r * 512) + 8 * lane;
          *(f32x4*)o = (f32x4){v[0], v[1], v[2], v[3]}; *(f32x4*)(o + 4) = (f32x4){v[4], v[5], v[6], v[7]};
          bf16_t* vt; size_t ldv; int key;
          if (smp) { vt = (bf16_t*)(ws + OFF_VBTS) + (size_t)(rs >> 4) * 512 * LKSP; ldv = LKSP; key = PAST + (rs & 15); }
          else { vt = (bf16_t*)(ws + OFF_VBTP) + (size_t)(r >> 12) * 512 * 4096; ldv = 4096; key = r & 4095; }
          const unsigned w4[4] = {r_vb.x, r_vb.y, r_vb.z, r_vb.w};
          if (smp) {
#pragma unroll
              for (int e = 0; e < 8; ++e) vt[(size_t)(8 * lane + e) * ldv + key] = (bf16_t)((e & 1) ? (w4[e >> 1] >> 16) : (w4[e >> 1] & 0xffffu)); } }
        { unpack8(r_pe, v);
#pragma unroll
          for (int e = 0; e < 8; ++e) { const float oth = __shfl_xor(v[e], 4); v[e] = (l8 < 4) ? v[e] * c64[e] - oth * s64[e] : v[e] * c64[e] + oth * s64[e]; }
          if (lane < 8) { float* o = p.out + (smp ? OUT_SROPE + (size_t)rs * 64 : OUT_PROPE + (size_t)r * 64) + 8 * lane;
              *(f32x4*)o = (f32x4){v[0], v[1], v[2], v[3]}; *(f32x4*)(o + 4) = (f32x4){v[4], v[5], v[6], v[7]};
              *(u32x4*)((bf16_t*)(ws + (smp ? OFF_KPES : OFF_KPEP)) + (size_t)crow * 64 + 8 * lane) = pack8(v); } }
        { unpack8(r_ki, v); rope32(v, lane, c32, s32);
          if (lane < 16) { float* o = p.out + (smp ? OUT_SIK + (size_t)rs * 128 : OUT_PIK + (size_t)r * 128) + 8 * lane;
              *(f32x4*)o = (f32x4){v[0], v[1], v[2], v[3]}; *(f32x4*)(o + 4) = (f32x4){v[4], v[5], v[6], v[7]};
              *(u32x4*)((bf16_t*)(ws + (smp ? OFF_KIS : OFF_KIP)) + (size_t)crow * 128 + 8 * lane) = pack8(v); } }
        if (lane < 2) { unpack8(r_wi, v); float* o = (float*)(ws + OFF_WI) + (size_t)r * 16 + 8 * lane;
            *(f32x4*)o = (f32x4){v[0], v[1], v[2], v[3]} * IDX_SCALE; *(f32x4*)(o + 4) = (f32x4){v[4], v[5], v[6], v[7]} * IDX_SCALE; }
#pragma unroll
        for (int which = 0; which < 2; ++which) { bf16_t* qrow = which ? qirow : qbrow;
#pragma unroll
            for (int sg = 0; sg < 4; ++sg) { unpack8(r_q[which][sg], v); rope32(v, lane, c32, s32); if ((lane & 15) < 4) *(u32x4*)(qrow + sg * 512 + 8 * lane) = pack8(v); } }
    }
    constexpr int VROWB = 1028;
    for (int t = blockIdx.x; t < MPR / 64; t += gridDim.x) {
        __syncthreads();
        const int tok0 = t * 64;
#pragma unroll
        for (int k = 0; k < 8; ++k) { const int c = k * 512 + tid, row = c >> 6, c16 = c & 63;
            const u32x4 d = *(const u32x4*)((const bf16_t*)(ws + OFF_SMALL) + (size_t)(tok0 + row) * 2304 + 1536 + c16 * 8);
            LAS unsigned* dstl = (LAS unsigned*)(lds + row * VROWB + c16 * 16); dstl[0] = d.x; dstl[1] = d.y; dstl[2] = d.z; dstl[3] = d.w; }
        __syncthreads();
        bf16_t* vrow = (bf16_t*)(ws + OFF_VBTP) + ((size_t)(tok0 >> 12) * 512 + tid) * 4096 + (tok0 & 4095);
#pragma unroll
        for (int k8 = 0; k8 < 8; ++k8) { unsigned w4[4];
#pragma unroll
            for (int j = 0; j < 4; ++j) { const unsigned lo = *(const LAS unsigned short*)(lds + (k8 * 8 + 2 * j) * VROWB + tid * 2), hi = *(const LAS unsigned short*)(lds + (k8 * 8 + 2 * j + 1) * VROWB + tid * 2); w4[j] = lo | (hi << 16); }
            *(u32x4*)(vrow + k8 * 8) = (u32x4){w4[0], w4[1], w4[2], w4[3]}; }
    }
    __syncthreads();
}

__device__ unsigned g_ctr[64 * 4];
DI int next_unit(const int tid, unsigned* ctr, volatile LAS int* slot) {
    __syncthreads();
    if (tid == 0) *slot = (int)atomicAdd(ctr, 1u);
    __syncthreads();
    int u = __builtin_amdgcn_readfirstlane(*slot); asm volatile("" : "+s"(u));
    return u;
}

template <int NP>
DI void idx_wave(const bf16_t* QI, const float* WI, int tok0, const bf16_t* KI, int k_lo, int k_hi, int nvalid, float* sc, int stride, int lane) {
    const int hf = lane >> 5, r32 = lane & 31;
    bf16x8 A[NP][8]; unsigned sg[NP];
#pragma unroll
    for (int pr = 0; pr < NP; ++pr) {
        const int token = tok0 + 2 * pr + (r32 >> 4), head = r32 & 15;
        const float w = fabsf(WI[(size_t)token * 16 + head]);
        const bf16_t* q = QI + (size_t)token * 2048 + head * 128 + 8 * hf;
#pragma unroll
        for (int s = 0; s < 8; ++s) { float v[8]; unpack8(*(const u32x4*)(q + 16 * s), v);
#pragma unroll
            for (int e = 0; e < 8; ++e) v[e] *= w;
            const u32x4 pk = pack8(v); A[pr][s] = *(const bf16x8*)&pk; }
        unsigned bits = 0;
#pragma unroll
        for (int tt = 0; tt < 2; ++tt)
#pragma unroll
            for (int i = 0; i < 8; ++i) { const int hd = 8 * ((i >> 2) & 1) + 4 * hf + (i & 3); if (WI[(size_t)(tok0 + 2 * pr + tt) * 16 + hd] < 0.f) bits |= 1u << (tt * 8 + i); }
        sg[pr] = bits;
    }
    for (int k0 = k_lo; k0 < k_hi; k0 += 32) {
        bf16x8 B[8]; const bf16_t* kp = KI + (size_t)(k0 + r32) * 128 + 8 * hf;
#pragma unroll
        for (int s = 0; s < 8; ++s) B[s] = *(const bf16x8*)(kp + 16 * s);
#pragma unroll
        for (int pr = 0; pr < NP; ++pr) {
            f32x16 d = {0, 0, 0, 0, 0, 0, 0, 0, 0, 0, 0, 0, 0, 0, 0, 0};
#pragma unroll
            for (int s = 0; s < 8; ++s) d = __builtin_amdgcn_mfma_f32_32x32x16_bf16(A[pr][s], B[s], d, 0, 0, 0);
            float v0 = 0.f, v1 = 0.f;
#pragma unroll
            for (int i = 0; i < 8; ++i) { const float a = fmaxf(d[i], 0.f), b = fmaxf(d[8 + i], 0.f);
                v0 += ((sg[pr] >> i) & 1u) ? -a : a; v1 += ((sg[pr] >> (8 + i)) & 1u) ? -b : b; }
            const float send = hf ? v0 : v1, recv = __shfl_xor(send, 32), res = (hf ? v1 : v0) + recv;
            const int key = k0 + r32;
            if (key < nvalid) sc[(size_t)(2 * pr + hf) * stride + key] = res;
        }
    }
}
DI void idx_block(const int tid, LAS unsigned char* lds, const bf16_t* QI, const float* WI, int tok0, const bf16_t* KI, int k_lo, int k_hi, float* sc, int stride) {
    constexpr int NP = 4, KROW = 272, BUF = 64 * KROW, W2OFF = 2 * BUF;
    const int lane = tid & 63, w = tid >> 6, hf = lane >> 5, r32 = lane & 31;
    bf16x8 A[NP][8];
#pragma unroll
    for (int pr = 0; pr < NP; ++pr) {
        const int token = tok0 + 2 * pr + (r32 >> 4), head = r32 & 15;
        const bf16_t* q = QI + (size_t)token * 2048 + head * 128 + 8 * hf;
#pragma unroll
        for (int s = 0; s < 8; ++s) A[pr][s] = *(const bf16x8*)(q + 16 * s);
#pragma unroll
        for (int s = 0; s < 2; ++s) {
            float v[8];
#pragma unroll
            for (int j = 0; j < 8; ++j) { const int hd = 8 * (j >> 2) + 4 * hf + (j & 3); v[j] = (r32 == s) ? WI[(size_t)(tok0 + 2 * pr + s) * 16 + hd] : 0.f; }
            *(LAS u32x4*)(lds + W2OFF + ((w * NP + pr) * 2 + s) * 1024 + lane * 16) = pack8(v);
        }
    }
    const int krow0 = tid >> 4, kc16 = tid & 15;
    const bf16_t* gk = KI + (size_t)krow0 * 128 + kc16 * 8;
    const int lk = krow0 * KROW + kc16 * 16;
    u32x4 sk0, sk1;
    const int nt = (k_hi - k_lo) >> 6;
    sk0 = *(const u32x4*)(gk + (size_t)k_lo * 128); sk1 = *(const u32x4*)(gk + (size_t)(k_lo + 32) * 128);
#pragma unroll 1
    for (int kc = 0; kc < nt; ++kc) {
        LAS unsigned char* buf = lds + (kc & 1) * BUF;
        *(LAS u32x4*)(buf + lk) = sk0; *(LAS u32x4*)(buf + lk + 32 * KROW) = sk1;
        __syncthreads();
        if (kc + 1 < nt) { const size_t kn = (size_t)(k_lo + 64 * (kc + 1)); sk0 = *(const u32x4*)(gk + kn * 128); sk1 = *(const u32x4*)(gk + (kn + 32) * 128); }
#pragma unroll 1
        for (int sub = 0; sub < 2; ++sub) {
            bf16x8 B[8]; const LAS unsigned char* kp = buf + (32 * sub + r32) * KROW + 16 * hf;
#pragma unroll
            for (int s = 0; s < 8; ++s) B[s] = *(const LAS bf16x8*)(kp + 32 * s);
            const int key = k_lo + 64 * kc + 32 * sub + r32;
#pragma unroll
            for (int p0 = 0; p0 < NP; p0 += 2) {
                f32x16 d[2];
#pragma unroll
                for (int k = 0; k < 2; ++k) d[k] = (f32x16){0, 0, 0, 0, 0, 0, 0, 0, 0, 0, 0, 0, 0, 0, 0, 0};
#pragma unroll
                for (int s = 0; s < 8; ++s)
#pragma unroll
                    for (int k = 0; k < 2; ++k) d[k] = __builtin_amdgcn_mfma_f32_32x32x16_bf16(A[p0 + k][s], B[s], d[k], 0, 0, 0);
#pragma unroll
                for (int k = 0; k < 2; ++k) {
                    const int pr = p0 + k;
                    f32x16 y = {0, 0, 0, 0, 0, 0, 0, 0, 0, 0, 0, 0, 0, 0, 0, 0};
#pragma unroll
                    for (int s = 0; s < 2; ++s) {
                        u32x4 xk; xk.x = cvt_pk_bf16(fmaxf(d[k][8 * s + 0], 0.f), fmaxf(d[k][8 * s + 1], 0.f)); xk.y = cvt_pk_bf16(fmaxf(d[k][8 * s + 2], 0.f), fmaxf(d[k][8 * s + 3], 0.f));
                        xk.z = cvt_pk_bf16(fmaxf(d[k][8 * s + 4], 0.f), fmaxf(d[k][8 * s + 5], 0.f)); xk.w = cvt_pk_bf16(fmaxf(d[k][8 * s + 6], 0.f), fmaxf(d[k][8 * s + 7], 0.f));
                        const bf16x8 w2 = *(const LAS bf16x8*)(lds + W2OFF + ((w * NP + pr) * 2 + s) * 1024 + lane * 16);
                        y = __builtin_amdgcn_mfma_f32_32x32x16_bf16(w2, *(const bf16x8*)&xk, y, 0, 0, 0);
                    }
                    if (hf == 0) { sc[(size_t)(2 * pr) * stride + key] = y[0]; sc[(size_t)(2 * pr + 1) * stride + key] = y[1]; }
                }
            }
        }
    }
}
DI void phase_index(const Params& p, const int tid, unsigned char* ws, LAS unsigned char* lds, int rep) {
    unsigned* ctr = &g_ctr[0 * 64]; (void)rep; volatile LAS int* slot = (volatile LAS int*)(lds + 131072);
    const int lane = tid & 63, w = __builtin_amdgcn_readfirstlane(tid >> 6);
    const bf16_t* QI = (const bf16_t*)(ws + OFF_QI); const float* WI = (const float*)(ws + OFF_WI);
    for (;;) {
        int u = next_unit(tid, ctr, slot);
        if (u >= 64 + 576) break;
        if (u < 64) {
            const int b = u >> 3, sg = u & 7, k_lo = 32 * ((65 * sg) / 8), k_hi = 32 * ((65 * (sg + 1)) / 8);
            idx_wave<1>(QI, WI, MPR + b * 16 + 2 * w, (const bf16_t*)(ws + OFF_KIS) + (size_t)b * LKS * 128, k_lo, k_hi, LKS,
                        (float*)(ws + OFF_SCORE_S) + (size_t)(b * 16 + 2 * w) * LKSP, LKSP, lane);
        } else {
            u -= 64; int g = 7; while (u >= 16 * (g + 1)) { u -= 16 * (g + 1); --g; }
            const int seg = u % (g + 1), rem = u / (g + 1), b = rem & 1, c = 8 * g + (rem >> 1);
            const int lvis = 64 * (c + 1), k_lo = seg * 512, k_hi = (k_lo + 512 < lvis) ? k_lo + 512 : lvis;
            if (k_lo < k_hi)
                idx_block(tid, lds, QI, WI, b * 4096 + c * 64 + 8 * w, (const bf16_t*)(ws + OFF_KIP) + (size_t)b * 4096 * 128, k_lo, k_hi,
                          (float*)(ws + OFF_SCORE) + (size_t)b * TRI + (size_t)4096 * (c * (c + 1) / 2) + (size_t)(8 * w) * lvis, lvis);
        }
    }
}

DI unsigned fkey(float f) { const unsigned u = __float_as_uint(f); return (u & 0x80000000u) ? ~u : (u | 0x80000000u); }
DI void topk_radix(const float* sc, int n, int nw, unsigned* mrow, LAS int* hist, int lane) {
    unsigned prefix = 0, pmask = 0; int kk = 256;
    for (int pass = 0; pass < 4; ++pass) {
        const int shift = 24 - 8 * pass;
        for (int i = lane; i < 256; i += 64) hist[i] = 0;
        __builtin_amdgcn_fence(__ATOMIC_ACQ_REL, "workgroup");
        for (int i = lane; i < n; i += 64) { const unsigned k = fkey(sc[i]); if ((k & pmask) == prefix) atomicAdd((int*)(hist + ((k >> shift) & 255u)), 1); }
        __builtin_amdgcn_fence(__ATOMIC_ACQ_REL, "workgroup");
        const int h0 = hist[4 * lane], h1 = hist[4 * lane + 1], h2 = hist[4 * lane + 2], h3 = hist[4 * lane + 3];
        const int s = h0 + h1 + h2 + h3; int incl = s;
#pragma unroll
        for (int d = 1; d < 64; d <<= 1) { const int o = __shfl_down(incl, d); if (lane + d < 64) incl += o; }
        int a = incl - s, found = -1, nk = 0;
        if (a < kk && kk <= a + h3) { found = 4 * lane + 3; nk = kk - a; } a += h3;
        if (found < 0 && a < kk && kk <= a + h2) { found = 4 * lane + 2; nk = kk - a; } a += h2;
        if (found < 0 && a < kk && kk <= a + h1) { found = 4 * lane + 1; nk = kk - a; } a += h1;
        if (found < 0 && a < kk && kk <= a + h0) { found = 4 * lane; nk = kk - a; }
        const unsigned long long bal = __ballot(found >= 0); const int src = bal ? (__ffsll((long long)bal) - 1) : 0;
        found = __shfl(found, src); kk = __shfl(nk, src);
        prefix |= ((unsigned)found) << shift; pmask |= 255u << shift;
        __builtin_amdgcn_fence(__ATOMIC_ACQ_REL, "workgroup");
    }
    int eqbase = 0;
    for (int i0 = 0; i0 < n; i0 += 64) {
        const int i = i0 + lane; const bool in = i < n; const unsigned k = in ? fkey(sc[i]) : 0u;
        const bool gt = in && k > prefix, eq = in && k == prefix;
        const unsigned long long be = __ballot(eq); const int rank = eqbase + __popcll(be & ((1ull << lane) - 1ull));
        const bool sel = gt || (eq && rank < kk); eqbase += __popcll(be);
        const unsigned long long bs = __ballot(sel);
        if (lane == 0) { mrow[i0 >> 5] = (unsigned)bs; if ((i0 >> 5) + 1 < nw) mrow[(i0 >> 5) + 1] = (unsigned)(bs >> 32); }
    }
}
DI void phase_topk(const Params& p, const int tid, unsigned char* ws, LAS unsigned char* lds) {
    const int lane = tid & 63, w = __builtin_amdgcn_readfirstlane(tid >> 6), wv = blockIdx.x * 8 + w, nwv = gridDim.x * 8;
    constexpr int NCAND = 512;
    LAS int* hist = (LAS int*)(lds + w * 8192);
    LAS unsigned* ckey = (LAS unsigned*)(lds + w * 8192 + 1024);
    LAS int* cidx = (LAS int*)(lds + w * 8192 + 1024 + 2048);
    LAS unsigned* mk = (LAS unsigned*)(lds + w * 8192 + 1024 + 4096);
    for (int r = wv; r < MR; r += nwv) {
        const float* sc; int n;
        if (r < MPR) { const int b = r >> 12, t = r & 4095, c = t >> 6; n = 64 * (c + 1); sc = (const float*)(ws + OFF_SCORE) + (size_t)b * TRI + (size_t)4096 * (c * (c + 1) / 2) + (size_t)(t & 63) * n; }
        else { n = LKS; sc = (const float*)(ws + OFF_SCORE_S) + (size_t)(r - MPR) * LKSP; }
        unsigned* mrow = (unsigned*)(ws + OFF_MASK) + (size_t)r * 128;
        const int nw = (n + 31) >> 5;
        if (n <= 256) { for (int i = lane; i < nw; i += 64) { const int rem = n - 32 * i; mrow[i] = rem >= 32 ? 0xffffffffu : ((1u << rem) - 1u); } continue; }
        f32x4 v[16]; float mn = INFINITY, mx = -INFINITY;
#pragma unroll
        for (int j = 0; j < 16; ++j) { const int base = (j * 64 + lane) * 4; v[j] = (f32x4){-INFINITY, -INFINITY, -INFINITY, -INFINITY}; if (base < n) v[j] = *(const f32x4*)(sc + base); }
#pragma unroll
        for (int j = 0; j < 16; ++j) { const bool ok = (j * 64 + lane) * 4 < n;
#pragma unroll
            for (int e = 0; e < 4; ++e) { mx = fmaxf(mx, v[j][e]); mn = fminf(mn, ok ? v[j][e] : INFINITY); } }
#pragma unroll
        for (int d = 1; d < 64; d <<= 1) { mn = fminf(mn, __shfl_xor(mn, d)); mx = fmaxf(mx, __shfl_xor(mx, d)); }
        const float scale = (mx > mn) ? 255.0f / (mx - mn) : 0.f;
        for (int i = lane; i < 256; i += 64) hist[i] = 0;
        if (lane == 0) mk[128] = 0u;
        __builtin_amdgcn_fence(__ATOMIC_ACQ_REL, "workgroup");
#pragma unroll
        for (int j = 0; j < 16; ++j) if ((j * 64 + lane) * 4 < n) {
#pragma unroll
            for (int e = 0; e < 4; ++e) { int bk = (int)((v[j][e] - mn) * scale); bk = bk > 255 ? 255 : (bk < 0 ? 0 : bk); atomicAdd((int*)(hist + bk), 1); } }
        __builtin_amdgcn_fence(__ATOMIC_ACQ_REL, "workgroup");
        const int h0 = hist[4 * lane], h1 = hist[4 * lane + 1], h2 = hist[4 * lane + 2], h3 = hist[4 * lane + 3];
        const int s = h0 + h1 + h2 + h3; int incl = s;
#pragma unroll
        for (int d = 1; d < 64; d <<= 1) { const int o = __shfl_down(incl, d); if (lane + d < 64) incl += o; }
        int a = incl - s, found = -1, nk = 0, hb = 0;
        if (a < 256 && 256 <= a + h3) { found = 4 * lane + 3; nk = 256 - a; hb = h3; } a += h3;
        if (found < 0 && a < 256 && 256 <= a + h2) { found = 4 * lane + 2; nk = 256 - a; hb = h2; } a += h2;
        if (found < 0 && a < 256 && 256 <= a + h1) { found = 4 * lane + 1; nk = 256 - a; hb = h1; } a += h1;
        if (found < 0 && a < 256 && 256 <= a + h0) { found = 4 * lane; nk = 256 - a; hb = h0; }
        const unsigned long long bal = __ballot(found >= 0); const int src = bal ? (__ffsll((long long)bal) - 1) : 0;
        const int B = __shfl(found, src); nk = __shfl(nk, src); hb = __shfl(hb, src);
        if (hb > NCAND) { __builtin_amdgcn_fence(__ATOMIC_ACQ_REL, "workgroup"); topk_radix(sc, n, nw, mrow, hist, lane); continue; }
#pragma unroll
        for (int j = 0; j < 16; ++j) {
            const int base = (j * 64 + lane) * 4; const bool ok = base < n; unsigned nib = 0;
#pragma unroll
            for (int e = 0; e < 4; ++e) { int bk = (int)((v[j][e] - mn) * scale); bk = bk > 255 ? 255 : (bk < 0 ? 0 : bk);
                if (ok && bk > B) nib |= 1u << e;
                if (ok && bk == B) { const unsigned pos = atomicAdd((unsigned*)(mk + 128), 1u); if (pos < (unsigned)NCAND) { ckey[pos] = fkey(v[j][e]); cidx[pos] = base + e; } } }
            unsigned wd = nib << (4 * (lane & 7));
            wd |= __shfl_xor(wd, 1); wd |= __shfl_xor(wd, 2); wd |= __shfl_xor(wd, 4);
            if ((lane & 7) == 0 && j * 8 + (lane >> 3) < 128) mk[j * 8 + (lane >> 3)] = wd;
        }
        __builtin_amdgcn_fence(__ATOMIC_ACQ_REL, "workgroup");
        const int ncand = hb;
        for (int i = lane; i < ncand; i += 64) {
            const unsigned ki = ckey[i]; const int ii = cidx[i]; int rank = 0;
            for (int j = 0; j < ncand; ++j) { const unsigned kj = ckey[j]; rank += (kj > ki || (kj == ki && cidx[j] < ii)) ? 1 : 0; }
            if (rank < nk) atomicOr((unsigned*)(mk + (ii >> 5)), 1u << (ii & 31));
        }
        __builtin_amdgcn_fence(__ATOMIC_ACQ_REL, "workgroup");
        for (int i = lane; i < nw; i += 64) mrow[i] = mk[i];
        __builtin_amdgcn_fence(__ATOMIC_ACQ_REL, "workgroup");
    }
}

template <int DQK, bool MASK>
DI void attn_wave(const double* T, int lane, const bf16_t* qrow, int qpos, const bf16_t* kbase, int ldk, const bf16_t* kpe,
                  const bf16_t* vt, int ldv, int nkeys, int kt_begin, int kt_end, const unsigned* mrow, float qscale, float& m_out, float& l_out, f32x4 (&acc)[8]) {
    constexpr int NS = DQK / 32;
    const int r = lane & 15, q = lane >> 4;
    bf16x8 qf[NS];
#pragma unroll
    for (int s = 0; s < 4; ++s) { float v[8]; unpack8(*(const u32x4*)(qrow + 32 * s + 8 * q), v);
#pragma unroll
        for (int e = 0; e < 8; ++e) v[e] *= qscale;
        const u32x4 pk = pack8(v); qf[s] = *(const bf16x8*)&pk; }
    if (DQK == 192) { float x1[8], x2[8]; unpack8(*(const u32x4*)(qrow + 128 + 8 * q), x1); unpack8(*(const u32x4*)(qrow + 160 + 8 * q), x2);
#pragma unroll
        for (int e = 0; e < 8; ++e) { float c, s; rope_cs(T, qpos, 8 * q + e, c, s); const float a = x1[e], b = x2[e]; x1[e] = (a * c - b * s) * qscale; x2[e] = (b * c + a * s) * qscale; }
        const u32x4 p1 = pack8(x1), p2 = pack8(x2); qf[NS - 2] = *(const bf16x8*)&p1; qf[NS - 1] = *(const bf16x8*)&p2; }
    float m = -INFINITY, l = 0.f;
#pragma unroll
    for (int i = 0; i < 8; ++i) acc[i] = (f32x4){0.f, 0.f, 0.f, 0.f};
#pragma unroll 1
    for (int kt = kt_begin; kt < kt_end; ++kt) {
        const int k0 = kt * 32;
        f32x4 s0 = (f32x4){0.f, 0.f, 0.f, 0.f}, s1 = (f32x4){0.f, 0.f, 0.f, 0.f};
#pragma unroll
        for (int t = 0; t < 2; ++t) { const int key = k0 + 8 * (r >> 2) + 4 * t + (r & 3); const bf16_t* kr = kbase + (size_t)key * ldk + 8 * q;
            bf16x8 kf[NS];
#pragma unroll
            for (int s = 0; s < 4; ++s) kf[s] = *(const bf16x8*)(kr + 32 * s);
            if (DQK == 192) { const bf16_t* k2 = kpe + (size_t)key * 64 + 8 * q; kf[NS - 2] = *(const bf16x8*)k2; kf[NS - 1] = *(const bf16x8*)(k2 + 32); }
#pragma unroll
            for (int s = 0; s < NS; ++s) { if (t == 0) s0 = __builtin_amdgcn_mfma_f32_16x16x32_bf16(kf[s], qf[s], s0, 0, 0, 0); else s1 = __builtin_amdgcn_mfma_f32_16x16x32_bf16(kf[s], qf[s], s1, 0, 0, 0); } }
        bf16x8 vf[8];
#pragma unroll
        for (int i = 0; i < 8; ++i) vf[i] = *(const bf16x8*)(vt + (size_t)(16 * i + r) * ldv + k0 + 8 * q);
        float sv[8] = {s0[0], s0[1], s0[2], s0[3], s1[0], s1[1], s1[2], s1[3]};
        unsigned bits = 0xffu;
        if (MASK) bits = (mrow[kt] >> (8 * q)) & 0xffu;
        if (k0 + 32 > nkeys) {
#pragma unroll
            for (int j = 0; j < 8; ++j) if (k0 + 8 * q + j >= nkeys) bits &= ~(1u << j); }
        float tm = -INFINITY;
#pragma unroll
        for (int j = 0; j < 8; ++j) { sv[j] = ((bits >> j) & 1u) ? sv[j] : -INFINITY; tm = fmaxf(tm, sv[j]); }
        tm = fmaxf(tm, __shfl_xor(tm, 16)); tm = fmaxf(tm, __shfl_xor(tm, 32));
        const float mn = fmaxf(m, tm), mu = (mn == -INFINITY) ? 0.f : mn;
        const float al = __builtin_amdgcn_exp2f(m - mu);
        m = mn;
        float pj[8], ps = 0.f;
#pragma unroll
        for (int j = 0; j < 8; ++j) { pj[j] = __builtin_amdgcn_exp2f(sv[j] - mu); ps += pj[j]; }
        l = l * al + ps;
#pragma unroll
        for (int i = 0; i < 8; ++i) acc[i] = acc[i] * al;
        const u32x4 pk = pack8(pj); const bf16x8 pf = *(const bf16x8*)&pk;
#pragma unroll
        for (int i = 0; i < 8; ++i) acc[i] = __builtin_amdgcn_mfma_f32_16x16x32_bf16(vf[i], pf, acc[i], 0, 0, 0);
        asm volatile("" ::: "memory");
    }
    m_out = m; l_out = l;
}
DI void sample_combine_store(const int tid, LAS unsigned char* lds, int w, float m, float l, f32x4 (&acc)[8], bf16_t* orow) {
    const int lane = tid & 63, q = lane >> 4;
    LAS float* st = (LAS float*)lds;
    if (w >= 4) { LAS float* p = st + (size_t)(w - 4) * 34 * 64 + lane; p[0] = m; p[64] = l;
#pragma unroll
        for (int i = 0; i < 8; ++i)
#pragma unroll
            for (int j = 0; j < 4; ++j) p[(2 + 4 * i + j) * 64] = acc[i][j]; }
    __syncthreads();
    if (w < 4) { const LAS float* p = st + (size_t)w * 34 * 64 + lane; const float m2 = p[0], l2 = p[64];
        const float M = fmaxf(m, m2), mu = (M == -INFINITY) ? 0.f : M, a1 = __builtin_amdgcn_exp2f(m - mu), a2 = __builtin_amdgcn_exp2f(m2 - mu);
        float lt = l * a1 + l2 * a2; lt += __shfl_xor(lt, 16); lt += __shfl_xor(lt, 32);
        const float inv = lt > 0.f ? 1.0f / lt : 0.f;
#pragma unroll
        for (int i = 0; i < 8; ++i) { f32x4 o;
#pragma unroll
            for (int j = 0; j < 4; ++j) o[j] = (acc[i][j] * a1 + p[(2 + 4 * i + j) * 64] * a2) * inv;
            u32x2 w2; w2.x = cvt_pk_bf16(o[0], o[1]); w2.y = cvt_pk_bf16(o[2], o[3]); *(u32x2*)(orow + 16 * i + 4 * q) = w2; } }
}
template <int DQK, bool MASK>
DI void attn_block(const double* T, const int tid, LAS unsigned char* lds, const bf16_t* const (&qrow)[2], const int (&qpos)[2], const unsigned* const (&mrow)[2], bf16_t* const (&orow)[2],
                   const bf16_t* kbase, int ldk, const bf16_t* kpe, const bf16_t* vt, int ldv, int ntile_blk, int ntile_w, float qscale) {
    constexpr int NS = DQK / 32, KROW = DQK * 2 + 16, KBYTES = 64 * KROW, VROW = 144, VBYTES = 128 * VROW, BUF = KBYTES + VBYTES;
    const int lane = tid & 63, r = lane & 15, q = lane >> 4;
    bf16x8 qf[2][NS];
#pragma unroll
    for (int g = 0; g < 2; ++g) {
#pragma unroll
        for (int s = 0; s < 4; ++s) { float v[8]; unpack8(*(const u32x4*)(qrow[g] + 32 * s + 8 * q), v);
#pragma unroll
            for (int e = 0; e < 8; ++e) v[e] *= qscale;
            const u32x4 pk = pack8(v); qf[g][s] = *(const bf16x8*)&pk; }
        if (DQK == 192) { float x1[8], x2[8]; unpack8(*(const u32x4*)(qrow[g] + 128 + 8 * q), x1); unpack8(*(const u32x4*)(qrow[g] + 160 + 8 * q), x2);
#pragma unroll
            for (int e = 0; e < 8; ++e) { float c, s; rope_cs(T, qpos[g], 8 * q + e, c, s); const float a = x1[e], b = x2[e]; x1[e] = (a * c - b * s) * qscale; x2[e] = (b * c + a * s) * qscale; }
            const u32x4 p1 = pack8(x1), p2 = pack8(x2); qf[g][NS - 2] = *(const bf16x8*)&p1; qf[g][NS - 1] = *(const bf16x8*)&p2; }
    }
    float m[2], l[2]; f32x4 acc[2][8];
#pragma unroll
    for (int g = 0; g < 2; ++g) { m[g] = -INFINITY; l[g] = 0.f;
#pragma unroll
        for (int i = 0; i < 8; ++i) acc[g][i] = (f32x4){0.f, 0.f, 0.f, 0.f}; }
    const int krow0 = tid >> 4, kc16 = tid & 15;
    const int prow = tid >> 3, pc = tid & 7;
    const int vrow0 = tid >> 3, vc = tid & 7;
    const bf16_t* gk = kbase + (size_t)krow0 * ldk + kc16 * 8;
    const bf16_t* gp = (DQK == 192) ? kpe + (size_t)prow * 64 + pc * 8 : nullptr;
    const bf16_t* gv = vt + (size_t)vrow0 * ldv + vc * 8;
    const int lk = krow0 * KROW + kc16 * 16, lp = prow * KROW + 256 + pc * 16, lv = KBYTES + vrow0 * VROW + vc * 16;
    u32x4 sk0, sk1, sp, sv0, sv1;
    sp = (u32x4){0u, 0u, 0u, 0u};
#define AB_ISSUE(kc) do { const size_t k0_ = (size_t)(kc) * 64; sk0 = *(const u32x4*)(gk + k0_ * ldk); sk1 = *(const u32x4*)(gk + (k0_ + 32) * ldk); \
        if (DQK == 192) sp = *(const u32x4*)(gp + k0_ * 64); sv0 = *(const u32x4*)(gv + k0_); sv1 = *(const u32x4*)(gv + (size_t)64 * ldv + k0_); } while (0)
    AB_ISSUE(0);
    u32x2 mnext[2] = {(u32x2){0u, 0u}, (u32x2){0u, 0u}};
    if (MASK) {
#pragma unroll
        for (int g = 0; g < 2; ++g) mnext[g] = *(const u32x2*)(mrow[g]);
    }
#pragma unroll 1
    for (int kc = 0; kc < ntile_blk; ++kc) {
        u32x2 mcur[2] = {mnext[0], mnext[1]};
        LAS unsigned char* buf = lds + (kc & 1) * BUF;
        *(LAS u32x4*)(buf + lk) = sk0; *(LAS u32x4*)(buf + lk + 32 * KROW) = sk1;
        if (DQK == 192) *(LAS u32x4*)(buf + lp) = sp;
        *(LAS u32x4*)(buf + lv) = sv0; *(LAS u32x4*)(buf + lv + 64 * VROW) = sv1;
        __syncthreads();
        if (kc + 1 < ntile_blk) { AB_ISSUE(kc + 1);
            if (MASK) {
#pragma unroll
                for (int g = 0; g < 2; ++g) mnext[g] = *(const u32x2*)(mrow[g] + 2 * (kc + 1)); } }
        if (kc < ntile_w) {
#pragma unroll 1
            for (int sub = 0; sub < 2; ++sub) {
                f32x4 s0[2], s1[2];
#pragma unroll
                for (int g = 0; g < 2; ++g) { s0[g] = (f32x4){0.f, 0.f, 0.f, 0.f}; s1[g] = (f32x4){0.f, 0.f, 0.f, 0.f}; }
#pragma unroll
                for (int t = 0; t < 2; ++t) {
                    const LAS unsigned char* kr = buf + (32 * sub + 8 * (r >> 2) + 4 * t + (r & 3)) * KROW + 16 * q;
                    bf16x8 kf[NS];
#pragma unroll
                    for (int s = 0; s < NS; ++s) kf[s] = *(const LAS bf16x8*)(kr + 64 * s);
#pragma unroll
                    for (int g = 0; g < 2; ++g)
#pragma unroll
                        for (int s = 0; s < NS; ++s) { if (t == 0) s0[g] = __builtin_amdgcn_mfma_f32_16x16x32_bf16(kf[s], qf[g][s], s0[g], 0, 0, 0); else s1[g] = __builtin_amdgcn_mfma_f32_16x16x32_bf16(kf[s], qf[g][s], s1[g], 0, 0, 0); }
                }
                bf16x8 vf[8];
#pragma unroll
                for (int i = 0; i < 8; ++i) vf[i] = *(const LAS bf16x8*)(buf + KBYTES + (16 * i + r) * VROW + 64 * sub + 16 * q);
                bf16x8 pf[2];
#pragma unroll
                for (int g = 0; g < 2; ++g) {
                    float sv[8] = {s0[g][0], s0[g][1], s0[g][2], s0[g][3], s1[g][0], s1[g][1], s1[g][2], s1[g][3]};
                    float tm = -INFINITY;
                    if (MASK) { const unsigned bits = ((sub ? mcur[g].y : mcur[g].x) >> (8 * q)) & 0xffu;
#pragma unroll
                        for (int j = 0; j < 8; ++j) sv[j] = ((bits >> j) & 1u) ? sv[j] : -INFINITY; }
#pragma unroll
                    for (int j = 0; j < 8; ++j) tm = fmaxf(tm, sv[j]);
                    if (__builtin_amdgcn_ballot_w64(tm > m[g] + 8.0f) != 0ull) {
                        tm = fmaxf(tm, __shfl_xor(tm, 16)); tm = fmaxf(tm, __shfl_xor(tm, 32));
                        const float mn = fmaxf(m[g], tm), mu = (mn == -INFINITY) ? 0.f : mn;
                        const float al = __builtin_amdgcn_exp2f(m[g] - mu);
                        m[g] = mn; l[g] *= al;
#pragma unroll
                        for (int i = 0; i < 8; ++i) acc[g][i] = acc[g][i] * al;
                    }
                    const float mu = (m[g] == -INFINITY) ? 0.f : m[g];
                    float pj[8], ps = 0.f;
#pragma unroll
                    for (int j = 0; j < 8; ++j) { pj[j] = __builtin_amdgcn_exp2f(sv[j] - mu); ps += pj[j]; }
                    l[g] += ps;
                    const u32x4 pk = pack8(pj); pf[g] = *(const bf16x8*)&pk;
                }
#pragma unroll
                for (int g = 0; g < 2; ++g)
#pragma unroll
                    for (int i = 0; i < 8; ++i) acc[g][i] = __builtin_amdgcn_mfma_f32_16x16x32_bf16(vf[i], pf[g], acc[g][i], 0, 0, 0);
            }
        }
    }
#undef AB_ISSUE
#pragma unroll
    for (int g = 0; g < 2; ++g) {
        float lt = l[g]; lt += __shfl_xor(lt, 16); lt += __shfl_xor(lt, 32);
        const float inv = lt > 0.f ? 1.0f / lt : 0.f;
#pragma unroll
        for (int i = 0; i < 8; ++i) { const f32x4 o = acc[g][i] * inv; u32x2 w2; w2.x = cvt_pk_bf16(o[0], o[1]); w2.y = cvt_pk_bf16(o[2], o[3]);
            *(u32x2*)(orow[g] + 16 * i + 4 * q) = w2; }
    }
}
constexpr float LOG2E = 1.4426950408889634f;
constexpr float QS_DSA = 0.08838834764831845f * LOG2E;
constexpr float QS_MLA = 0.07216878364870323f * LOG2E;

DI void phase_attn_a(const Params& p, const int tid, unsigned char* ws, LAS unsigned char* lds) {
    unsigned* ctr = &g_ctr[1 * 64]; volatile LAS int* slot = (volatile LAS int*)(lds + 131072);
    const int lane = tid & 63, w = __builtin_amdgcn_readfirstlane(tid >> 6), cl = lane & 15;
    bf16_t* QB = (bf16_t*)(ws + OFF_QB); const unsigned* MK = (const unsigned*)(ws + OFF_MASK);
    for (;;) {
        const int u = next_unit(tid, ctr, slot);
        if (u >= 64) break;
        {
            const int su = u & 31, b = su >> 2, g = su & 3, hd = 4 * g + (w & 3), half = w >> 2, kt0 = half ? 33 : 0, kt1 = half ? 65 : 33, token = MPR + b * 16 + cl;
            float m, l; f32x4 acc[8];
            if (u < 32) {
                attn_wave<128, true>(p.T, lane, QB + (size_t)token * 2048 + hd * 128, 0, (const bf16_t*)(ws + OFF_KBS) + (size_t)b * LKS * 512 + g * 128, 512, nullptr,
                                     (const bf16_t*)(ws + OFF_VBTS) + (size_t)(b * 4 + g) * 128 * LKSP, LKSP, LKS, kt0, kt1, MK + (size_t)token * 128, QS_DSA, m, l, acc);
                sample_combine_store(tid, lds, w, m, l, acc, QB + (size_t)token * 2048 + hd * 128);
            } else {
                attn_wave<192, false>(p.T, lane, (const bf16_t*)(ws + OFF_QSMLA) + (size_t)(b * 16 + cl) * 3072 + hd * 192, PAST + cl, (const bf16_t*)(ws + OFF_KNS) + (size_t)b * LKS * 2048 + hd * 128, 2048,
                                      (const bf16_t*)(ws + OFF_KPES) + (size_t)b * LKS * 64, (const bf16_t*)(ws + OFF_VTS) + (size_t)(b * 16 + hd) * 128 * LKSP, LKSP, LKS, kt0, kt1, nullptr, QS_MLA, m, l, acc);
                sample_combine_store(tid, lds, w, m, l, acc, (bf16_t*)(ws + OFF_QI) + (size_t)token * 2048 + hd * 128);
            }
        }
    }
    unsigned* ctr2 = &g_ctr[3 * 64];
    for (;;) {
        int u = next_unit(tid, ctr2, slot);
        if (u >= 512) break;
        {
            const int c = 63 - (u >> 3), b = (u >> 2) & 1, g = u & 3;
            const int head = 4 * g + (w >> 1);
            const bf16_t* qr[2]; int qp[2] = {0, 0}; const unsigned* mr[2]; bf16_t* orw[2];
#pragma unroll
            for (int gq = 0; gq < 2; ++gq) { const int token = b * 4096 + 64 * c + 32 * (w & 1) + 16 * gq + cl; qr[gq] = QB + (size_t)token * 2048 + head * 128; orw[gq] = QB + (size_t)token * 2048 + head * 128; mr[gq] = MK + (size_t)token * 128; }
            attn_block<128, true>(p.T, tid, lds, qr, qp, mr, orw, (const bf16_t*)(ws + OFF_KBP) + (size_t)b * 4096 * 512 + g * 128, 512, nullptr,
                                  (const bf16_t*)(ws + OFF_VBTP) + (size_t)(b * 4 + g) * 128 * 4096, 4096, c + 1, c + 1, QS_DSA);
        }
    }
}
DI void phase_attn_b(const Params& p, const int tid, unsigned char* ws, LAS unsigned char* lds, int rep) {
    unsigned* ctr = &g_ctr[2 * 64]; (void)rep; volatile LAS int* slot = (volatile LAS int*)(lds + 131072);
    const int lane = tid & 63, w = __builtin_amdgcn_readfirstlane(tid >> 6), cl = lane & 15;
    for (;;) {
        const int u = next_unit(tid, ctr, slot);
        if (u >= 512) break;
        const int qt = 15 - (u >> 5), b = (u >> 4) & 1, h = u & 15;
        const bf16_t* qr[2]; int qp[2]; const unsigned* mr[2] = {nullptr, nullptr}; bf16_t* orw[2];
#pragma unroll
        for (int gq = 0; gq < 2; ++gq) { const int t = 256 * qt + 32 * w + 16 * gq + cl, token = b * 4096 + t; qp[gq] = t;
            qr[gq] = (const bf16_t*)(ws + OFF_QMLA) + (size_t)token * 3072 + h * 192; orw[gq] = (bf16_t*)(ws + OFF_QI) + (size_t)token * 2048 + h * 128; }
        const int chunk = 4 * qt + (w >> 1);
        attn_block<192, false>(p.T, tid, lds, qr, qp, mr, orw, (const bf16_t*)(ws + OFF_KNP) + (size_t)b * 4096 * 2048 + h * 128, 2048, (const bf16_t*)(ws + OFF_KPEP) + (size_t)b * 4096 * 64,
                               (const bf16_t*)(ws + OFF_VTP) + (size_t)(b * 16 + h) * 128 * 4096, 4096, 4 * qt + 4, chunk + 1, QS_MLA);
    }
}

DI void phase_ln(const Params& p, const int tid, const float* src, const float* g, const float* bt, float* of32, bf16_t* obf, bool to_out, const float* sres, const float* part, int nsl) {
    const int lane = tid & 63, wv = blockIdx.x * 8 + __builtin_amdgcn_readfirstlane(tid >> 6), nwv = gridDim.x * 8;
    for (int r = wv; r < MR; r += nwv) {
        const float* s = src + (size_t)r * 2048; f32x4 v[8]; float sum = 0.f;
        if (r < MPR) {
#pragma unroll
            for (int i = 0; i < 8; ++i) v[i] = __builtin_nontemporal_load((const f32x4*)(s + 256 * i + 4 * lane));
        } else {
            const float* rs = sres + (size_t)(r - MPR) * 2048;
#pragma unroll
            for (int i = 0; i < 8; ++i) v[i] = *(const f32x4*)(rs + 256 * i + 4 * lane) * ALPHA;
            for (int sl0 = 0; sl0 < nsl; sl0 += 4) {
                f32x4 t[4][8];
#pragma unroll
                for (int k = 0; k < 4; ++k) { const float* pp = part + ((size_t)(sl0 + k) * 128 + (r - MPR)) * 2048;
#pragma unroll
                    for (int i = 0; i < 8; ++i) t[k][i] = *(const f32x4*)(pp + 256 * i + 4 * lane); }
#pragma unroll
                for (int k = 0; k < 4; ++k)
#pragma unroll
                    for (int i = 0; i < 8; ++i) v[i] = v[i] + t[k][i];
            }
        }
#pragma unroll
        for (int i = 0; i < 8; ++i) sum += v[i].x + v[i].y + v[i].z + v[i].w;
#pragma unroll
        for (int d = 1; d < 64; d <<= 1) sum += __shfl_xor(sum, d);
        const float mu = sum * (1.0f / 2048.0f); float sq = 0.f;
#pragma unroll
        for (int i = 0; i < 8; ++i) { v[i] = v[i] - mu; sq += v[i].x * v[i].x + v[i].y * v[i].y + v[i].z * v[i].z + v[i].w * v[i].w; }
#pragma unroll
        for (int d = 1; d < 64; d <<= 1) sq += __shfl_xor(sq, d);
        const float rstd = rsqrtf(sq * (1.0f / 2048.0f) + NORM_EPS);
        float* o = to_out ? (p.out + (r < MPR ? OUT_YP + (size_t)r * 2048 : OUT_YS + (size_t)(r - MPR) * 2048)) : of32 + (size_t)r * 2048;
#pragma unroll
        for (int i = 0; i < 8; ++i) { const int c = 256 * i + 4 * lane; const f32x4 y = v[i] * rstd * *(const f32x4*)(g + c) + *(const f32x4*)(bt + c);
            if (to_out) __builtin_nontemporal_store(y, (f32x4*)(o + c)); else *(f32x4*)(o + c) = y;
            if (obf) { u32x2 w2; w2.x = cvt_pk_bf16(y.x, y.y); w2.y = cvt_pk_bf16(y.z, y.w); *(u32x2*)(obf + (size_t)r * 2048 + c) = w2; } }
    }
}

DI void phase_fin_merged(const int tid, unsigned char* ws) {
    const size_t gtid = (size_t)blockIdx.x * NTHREADS + tid, gsz = (size_t)gridDim.x * NTHREADS;
    const float* P = (const float*)(ws + OFF_PART);
    for (size_t i = gtid; i < (size_t)MS * 512; i += gsz) {
        const int r = (int)(i >> 9), c = (int)(i & 511) * 4;
        f32x4 a = (f32x4){0.f, 0.f, 0.f, 0.f}, b = a;
        for (int sl = 0; sl < 8; ++sl) { a = a + *(const f32x4*)(P + ((size_t)sl * 128 + r) * 2048 + c); b = b + *(const f32x4*)(P + ((size_t)(sl + 8) * 128 + r) * 2048 + c); }
        const bf16_t* g = (const bf16_t*)(ws + OFF_GATES) + (size_t)(MPR + r) * 4096 + c;
        const u32x2 ga = *(const u32x2*)g, gb = *(const u32x2*)(g + 2048);
        const float o0 = sigmoidf(bflo(ga.x)) * a[0] + sigmoidf(bflo(gb.x)) * b[0], o1 = sigmoidf(bfhi(ga.x)) * a[1] + sigmoidf(bfhi(gb.x)) * b[1];
        const float o2 = sigmoidf(bflo(ga.y)) * a[2] + sigmoidf(bflo(gb.y)) * b[2], o3 = sigmoidf(bfhi(ga.y)) * a[3] + sigmoidf(bfhi(gb.y)) * b[3];
        u32x2 w2; w2.x = cvt_pk_bf16(o0, o1); w2.y = cvt_pk_bf16(o2, o3);
        *(u32x2*)((bf16_t*)(ws + OFF_MERGED) + (size_t)(MPR + r) * 2048 + c) = w2;
    }
}
DI void phase_fin_u(const int tid, unsigned char* ws) {
    const size_t gtid = (size_t)blockIdx.x * NTHREADS + tid, gsz = (size_t)gridDim.x * NTHREADS;
    const float* P = (const float*)(ws + OFF_PART);
    for (size_t i = gtid; i < (size_t)MS * 2048; i += gsz) {
        const int r = (int)(i >> 11), c = (int)(i & 2047) * 4;
        f32x4 a = (f32x4){0.f, 0.f, 0.f, 0.f};
        for (int sl = 0; sl < 8; ++sl) a = a + *(const f32x4*)(P + ((size_t)sl * 128 + r) * 8192 + c);
        float t0 = fmaxf(a[0], 0.f), t1 = fmaxf(a[1], 0.f), t2 = fmaxf(a[2], 0.f), t3 = fmaxf(a[3], 0.f);
        u32x2 w2; w2.x = cvt_pk_bf16(t0 * t0, t1 * t1); w2.y = cvt_pk_bf16(t2 * t2, t3 * t3);
        *(u32x2*)((bf16_t*)(ws + OFF_U) + (size_t)(MPR + r) * 8192 + c) = w2;
    }
}

__device__ unsigned g_bar[64 * 10];
DI unsigned xb_ld(unsigned* p) { return __hip_atomic_load(p, __ATOMIC_RELAXED, __HIP_MEMORY_SCOPE_AGENT); }
DI unsigned xb_add(unsigned* p, unsigned v) { return __hip_atomic_fetch_add(p, v, __ATOMIC_RELAXED, __HIP_MEMORY_SCOPE_AGENT); }
DI void fast_barrier() {
    asm volatile("s_waitcnt vmcnt(0)" ::: "memory");
    __syncthreads();
    if (threadIdx.x == 0) {
        __builtin_amdgcn_fence(__ATOMIC_RELEASE, "agent");
        asm volatile("s_waitcnt vmcnt(0)" ::: "memory");
        const unsigned gen0 = xb_ld(&g_bar[9 * 64]);
        const unsigned G = gridDim.x, g = blockIdx.x >> 5, ng = (G + 31u) >> 5, nin = (G - 32u * g) < 32u ? (G - 32u * g) : 32u;
        const unsigned old = xb_add(&g_bar[g * 64], 1u);
        if (old + 1u == nin) {
            xb_add(&g_bar[g * 64], 0u - nin);
            const unsigned ot = xb_add(&g_bar[8 * 64], 1u);
            if (ot + 1u == ng) { xb_add(&g_bar[8 * 64], 0u - ng); xb_add(&g_bar[9 * 64], 1u); }
        }
        unsigned sp = 0;
        while (xb_ld(&g_bar[9 * 64]) == gen0) { __builtin_amdgcn_s_sleep(1); if (++sp > (1u << 22)) break; }
        __builtin_amdgcn_fence(__ATOMIC_ACQUIRE, "agent");
        asm volatile("s_waitcnt vmcnt(0)" ::: "memory");
    }
    __syncthreads();
}

constexpr int NPHASE = 17;
__global__ void __launch_bounds__(NTHREADS, 2) mega(Params p) {
    extern __shared__ __attribute__((aligned(16))) unsigned char lds_raw[];
    LAS unsigned char* lds = (LAS unsigned char*)lds_raw;
    cg::grid_group grid = cg::this_grid();
#ifndef DUP_PHASE
#define DUP_PHASE -1
#endif
#ifndef PH_MASK
#define PH_MASK 0x1ffff
#endif
#define RUN_PHASE(n, rep_, ...) if (p.ph_lo <= (n) && (n) < p.ph_hi && (PH_MASK & (1 << (n)))) { if ((n) > p.ph_lo || (rep_)) { if ((n) == 1 && !(rep_)) grid.sync(); else fast_barrier(); } const int rep = (rep_); (void)rep; \
        unsigned wl_ = (unsigned)(unsigned long long)p.ws, wh_ = (unsigned)((unsigned long long)p.ws >> 32); asm volatile("" : "+v"(wl_), "+v"(wh_)); unsigned char* ws = (unsigned char*)(((unsigned long long)(unsigned)__builtin_amdgcn_readfirstlane(wh_) << 32) | (unsigned)__builtin_amdgcn_readfirstlane(wl_)); int tid = threadIdx.x; asm volatile("" : "+v"(tid)); __VA_ARGS__ }
    RUN_PHASE(0, 0, phase_prep(p, tid, ws, lds);)
#if DUP_PHASE == 0
    RUN_PHASE(0, 1, phase_prep(p, tid, ws, lds);)
#endif
    RUN_PHASE(1, 0, { pg8::Sched S; S.init1(2048, (const bf16_t*)(ws + OFF_XB), (const bf16_t*)(ws + OFF_WINT), 33, 41); EpiB E{EM_PROJ, ws, 2048}; pg8::gemm_phase(tid, lds, 2048, S, E); })
#if DUP_PHASE == 1
    RUN_PHASE(1, 1, { pg8::Sched S; S.init1(2048, (const bf16_t*)(ws + OFF_XB), (const bf16_t*)(ws + OFF_WINT), 33, 41); EpiB E{EM_PROJ, ws, 2048}; pg8::gemm_phase(tid, lds, 2048, S, E); })
#endif
    RUN_PHASE(2, 0, phase_post(p, tid, ws, lds);)
#if DUP_PHASE == 2
    RUN_PHASE(2, 1, phase_post(p, tid, ws, lds);)
#endif
    RUN_PHASE(3, 0, phase_index(p, tid, ws, lds, rep);)
#if DUP_PHASE == 3
    RUN_PHASE(3, 1, phase_index(p, tid, ws, lds, rep);)
#endif
    RUN_PHASE(4, 0, { if (blockIdx.x == 0 && tid == 0) __hip_atomic_store(&g_ctr[0 * 64], 0u, __ATOMIC_RELAXED, __HIP_MEMORY_SCOPE_AGENT); phase_topk(p, tid, ws, lds); })
#if DUP_PHASE == 4
    RUN_PHASE(4, 1, phase_topk(p, tid, ws, lds);)
#endif
    RUN_PHASE(5, 0, { pg8::Sched S; S.init3(512, (const bf16_t*)(ws + OFF_QLN) + (size_t)MPR * 512, (const bf16_t*)(ws + OFF_WUQT), 1, 12,
                                         (const bf16_t*)(ws + OFF_CKVS), (const bf16_t*)(ws + OFF_WUKT), 65, 8,
                                         (const bf16_t*)(ws + OFF_WUVT), (const bf16_t*)(ws + OFF_CKVS), 8, 65);
                  EpiB E{EM_UPS, ws, 2048}; pg8::gemm_phase(tid, lds, 512, S, E); })
#if DUP_PHASE == 5
    RUN_PHASE(5, 1, { pg8::Sched S; S.init3(512, (const bf16_t*)(ws + OFF_QLN) + (size_t)MPR * 512, (const bf16_t*)(ws + OFF_WUQT), 1, 12,
                                         (const bf16_t*)(ws + OFF_CKVS), (const bf16_t*)(ws + OFF_WUKT), 65, 8,
                                         (const bf16_t*)(ws + OFF_WUVT), (const bf16_t*)(ws + OFF_CKVS), 8, 65);
                  EpiB E{EM_UPS, ws, 2048}; pg8::gemm_phase(tid, lds, 512, S, E); })
#endif
    RUN_PHASE(6, 0, phase_attn_a(p, tid, ws, lds);)
#if DUP_PHASE == 6
    RUN_PHASE(6, 1, phase_attn_a(p, tid, ws, lds);)
#endif
    RUN_PHASE(7, 0, { if (blockIdx.x == 0 && tid == 0) { __hip_atomic_store(&g_ctr[1 * 64], 0u, __ATOMIC_RELAXED, __HIP_MEMORY_SCOPE_AGENT); __hip_atomic_store(&g_ctr[3 * 64], 0u, __ATOMIC_RELAXED, __HIP_MEMORY_SCOPE_AGENT); } pg8::Sched S; S.init3(512, (const bf16_t*)(ws + OFF_QLN), (const bf16_t*)(ws + OFF_WUQT), 32, 12,
                                         (const bf16_t*)(ws + OFF_CKVP), (const bf16_t*)(ws + OFF_WUKT), 32, 8,
                                         (const bf16_t*)(ws + OFF_WUVT), (const bf16_t*)(ws + OFF_CKVP), 8, 32);
                  EpiB E{EM_UPP, ws, 2048}; pg8::gemm_phase(tid, lds, 512, S, E); })
#if DUP_PHASE == 7
    RUN_PHASE(7, 1, { pg8::Sched S; S.init3(512, (const bf16_t*)(ws + OFF_QLN), (const bf16_t*)(ws + OFF_WUQT), 32, 12,
                                         (const bf16_t*)(ws + OFF_CKVP), (const bf16_t*)(ws + OFF_WUKT), 32, 8,
                                         (const bf16_t*)(ws + OFF_WUVT), (const bf16_t*)(ws + OFF_CKVP), 8, 32);
                  EpiB E{EM_UPP, ws, 2048}; pg8::gemm_phase(tid, lds, 512, S, E); })
#endif
    RUN_PHASE(8, 0, phase_attn_b(p, tid, ws, lds, rep);)
#if DUP_PHASE == 8
    RUN_PHASE(8, 1, phase_attn_b(p, tid, ws, lds, rep);)
#endif
    RUN_PHASE(9, 0, { if (blockIdx.x == 0 && tid == 0) __hip_atomic_store(&g_ctr[2 * 64], 0u, __ATOMIC_RELAXED, __HIP_MEMORY_SCOPE_AGENT); pg8::Sched S; S.init1(2048, (const bf16_t*)(ws + OFF_QI), (const bf16_t*)(ws + OFF_WO), 32, 8); S.add_second((const bf16_t*)(ws + OFF_QB), (const bf16_t*)(ws + OFF_WO) + (size_t)2048 * 2048, 32);
                  S.add_split((const bf16_t*)(ws + OFF_QI) + (size_t)MPR * 2048, (const bf16_t*)(ws + OFF_WO), 8, 16, 256); S.split_second((const bf16_t*)(ws + OFF_QB) + (size_t)MPR * 2048, (const bf16_t*)(ws + OFF_WO) + (size_t)2048 * 2048, 8);
                  EpiB E{EM_OF, ws, 2048}; pg8::gemm_phase(tid, lds, 2048, S, E); })
#if DUP_PHASE == 9
    RUN_PHASE(9, 1, { pg8::Sched S; S.init1(2048, (const bf16_t*)(ws + OFF_QI), (const bf16_t*)(ws + OFF_WO), 32, 8); S.add_second((const bf16_t*)(ws + OFF_QB), (const bf16_t*)(ws + OFF_WO) + (size_t)2048 * 2048, 32);
                  S.add_split((const bf16_t*)(ws + OFF_QI) + (size_t)MPR * 2048, (const bf16_t*)(ws + OFF_WO), 8, 16, 256); S.split_second((const bf16_t*)(ws + OFF_QB) + (size_t)MPR * 2048, (const bf16_t*)(ws + OFF_WO) + (size_t)2048 * 2048, 8);
                  EpiB E{EM_OF, ws, 2048}; pg8::gemm_phase(tid, lds, 2048, S, E); })
#endif
    RUN_PHASE(15, 0, phase_fin_merged(tid, ws);)
    RUN_PHASE(10, 0, { pg8::Sched S; S.init1(2048, (const bf16_t*)(ws + OFF_MERGED), (const bf16_t*)(ws + OFF_WO) + (size_t)2 * 2048 * 2048, 32, 8);
                   S.add_split((const bf16_t*)(ws + OFF_MERGED) + (size_t)MPR * 2048, (const bf16_t*)(ws + OFF_WO) + (size_t)2 * 2048 * 2048, 8, 8, 256);
                   EpiF E{EF_OUT, ws, p.x_prompt, p.x_sample}; pg8::gemm_phase(tid, lds, 2048, S, E); })
#if DUP_PHASE == 10
    RUN_PHASE(10, 1, { pg8::Sched S; S.init1(2048, (const bf16_t*)(ws + OFF_MERGED), (const bf16_t*)(ws + OFF_WO) + (size_t)2 * 2048 * 2048, 32, 8);
                   S.add_split((const bf16_t*)(ws + OFF_MERGED) + (size_t)MPR * 2048, (const bf16_t*)(ws + OFF_WO) + (size_t)2 * 2048 * 2048, 8, 8, 256);
                   EpiF E{EF_OUT, ws, p.x_prompt, p.x_sample}; pg8::gemm_phase(tid, lds, 2048, S, E); })
#endif
    RUN_PHASE(11, 0, { phase_ln(p, tid, (const float*)(ws + OFF_R1), p.ln1_g, p.ln1_b, (float*)(ws + OFF_H), (bf16_t*)(ws + OFF_HB), false, p.x_sample, (const float*)(ws + OFF_PART), 8);
                   const size_t gtid = (size_t)blockIdx.x * NTHREADS + tid, gsz = (size_t)gridDim.x * NTHREADS;
                   for (size_t i = gtid; i < (size_t)(MPAD - MR) * 256; i += gsz) *(u32x4*)((bf16_t*)(ws + OFF_HB) + (size_t)MR * 2048 + i * 8) = (u32x4){0u, 0u, 0u, 0u};
                   transpose_jobs(p, tid, lds, NTJ - 2, NTJ, blockIdx.x, gridDim.x); })
#if DUP_PHASE == 11
    RUN_PHASE(11, 1, { phase_ln(p, tid, (const float*)(ws + OFF_R1), p.ln1_g, p.ln1_b, (float*)(ws + OFF_H), (bf16_t*)(ws + OFF_HB), false, p.x_sample, (const float*)(ws + OFF_PART), 8);
                   const size_t gtid = (size_t)blockIdx.x * NTHREADS + tid, gsz = (size_t)gridDim.x * NTHREADS;
                   for (size_t i = gtid; i < (size_t)(MPAD - MR) * 256; i += gsz) *(u32x4*)((bf16_t*)(ws + OFF_HB) + (size_t)MR * 2048 + i * 8) = (u32x4){0u, 0u, 0u, 0u};
                   transpose_jobs(p, tid, lds, NTJ - 2, NTJ, blockIdx.x, gridDim.x); })
#endif
    RUN_PHASE(12, 0, { pg8::Sched S; S.init1(2048, (const bf16_t*)(ws + OFF_HB), (const bf16_t*)(ws + OFF_WUPT), 32, 32); S.add_split((const bf16_t*)(ws + OFF_HB) + (size_t)MPR * 2048, (const bf16_t*)(ws + OFF_WUPT), 32, 8, 256); EpiB E{EM_FFNUP, ws, 8192}; pg8::gemm_phase(tid, lds, 2048, S, E); })
#if DUP_PHASE == 12
    RUN_PHASE(12, 1, { pg8::Sched S; S.init1(2048, (const bf16_t*)(ws + OFF_HB), (const bf16_t*)(ws + OFF_WUPT), 32, 32); S.add_split((const bf16_t*)(ws + OFF_HB) + (size_t)MPR * 2048, (const bf16_t*)(ws + OFF_WUPT), 32, 8, 256); EpiB E{EM_FFNUP, ws, 8192}; pg8::gemm_phase(tid, lds, 2048, S, E); })
#endif
    RUN_PHASE(16, 0, phase_fin_u(tid, ws);)
    RUN_PHASE(13, 0, { pg8::Sched S; S.init1(8192, (const bf16_t*)(ws + OFF_U), (const bf16_t*)(ws + OFF_WDNT), 32, 8); S.add_split((const bf16_t*)(ws + OFF_U) + (size_t)MPR * 8192, (const bf16_t*)(ws + OFF_WDNT), 8, 8, 1024); EpiF E{EF_DOWN, ws, p.x_prompt, p.x_sample}; pg8::gemm_phase(tid, lds, 8192, S, E); })
#if DUP_PHASE == 13
    RUN_PHASE(13, 1, { pg8::Sched S; S.init1(8192, (const bf16_t*)(ws + OFF_U), (const bf16_t*)(ws + OFF_WDNT), 32, 8); S.add_split((const bf16_t*)(ws + OFF_U) + (size_t)MPR * 8192, (const bf16_t*)(ws + OFF_WDNT), 8, 8, 1024); EpiF E{EF_DOWN, ws, p.x_prompt, p.x_sample}; pg8::gemm_phase(tid, lds, 8192, S, E); })
#endif
    RUN_PHASE(14, 0, phase_ln(p, tid, (const float*)(ws + OFF_R1), p.ln2_g, p.ln2_b, nullptr, nullptr, true, (const float*)(ws + OFF_H) + (size_t)MPR * 2048, (const float*)(ws + OFF_PART), 8);)
#if DUP_PHASE == 14
    RUN_PHASE(14, 1, phase_ln(p, tid, (const float*)(ws + OFF_R1), p.ln2_g, p.ln2_b, nullptr, nullptr, true, (const float*)(ws + OFF_H) + (size_t)MPR * 2048, (const float*)(ws + OFF_PART), 8);)
#endif
#undef RUN_PHASE
}

static void add_tjob(Params& P, int& nj, const float* src, bf16_t* dst, int K, int ld, int c0, int ncols, int segw, int segs, int dld) {
    TJob& j = P.tj[nj]; j.src = src; j.dst = dst; j.K = K; j.ld = ld; j.c0 = c0; j.ncols = ncols; j.segw = segw; j.segs = segs; j.dld = dld; j.pad = 0;
    P.tfirst[nj + 1] = P.tfirst[nj] + (K / 64) * ((ncols + 63) / 64); ++nj;
}
extern "C" void kernel_launch(void* const* d_in, const int* in_sizes, int n_in, void* d_out, int out_size, void* d_ws, size_t ws_size, hipStream_t stream) {
    static int grid = 0;
    if (grid == 0) {
        if (n_in != 21 || ws_size < WS_NEED) { fprintf(stderr, "kernel_launch: bad inputs (n_in %d, ws %zu need %zu)\n", n_in, ws_size, (size_t)WS_NEED); grid = -1; return; }
        int dev = 0, cus = 0, per_cu = 0;
        hipGetDevice(&dev); hipDeviceGetAttribute(&cus, hipDeviceAttributeMultiprocessorCount, dev);
        if (hipFuncSetAttribute((const void*)mega, hipFuncAttributeMaxDynamicSharedMemorySize, LDS_BYTES) != hipSuccess) { fprintf(stderr, "kernel_launch: hipFuncSetAttribute failed\n"); grid = -1; return; }
        if (hipOccupancyMaxActiveBlocksPerMultiprocessor(&per_cu, (const void*)mega, NTHREADS, LDS_BYTES) != hipSuccess || per_cu < 1) { fprintf(stderr, "kernel_launch: occupancy query failed (%d)\n", per_cu); (void)hipGetLastError(); per_cu = 1; }
        grid = cus * per_cu;
    }
    if (grid < 0) return;
    Params P{};
    const float** ip = &P.x_prompt;
    for (int i = 0; i < 21; ++i) ip[i] = (const float*)d_in[i];
    P.out = (float*)d_out; P.ws = (unsigned char*)d_ws;
    for (int i = 0; i < 32; ++i) P.T[i] = pow(500000.0, -(double)i / 32.0);
    unsigned char* ws = (unsigned char*)d_ws;
    int nj = 0; P.tfirst[0] = 0;
    {
        bf16_t* wt = (bf16_t*)(ws + OFF_WINT);
        const int seg[11][3] = {{1088, 2048, 0}, {4160, 2048, 2048}, {6352, 2048, 4096}, {8400, 2048, 6144}, {0, 512, 8192}, {512, 512, 8704}, {3136, 512, 9216}, {3648, 512, 9728},
                                {1024, 64, 10240}, {6208, 128, 10304}, {6336, 16, 10432}};
        for (int s = 0; s < 11; ++s) add_tjob(P, nj, P.w_in, wt + (size_t)seg[s][2] * 2048, 2048, 10448, seg[s][0], seg[s][1], 1 << 30, 0, 2048);
    }
    add_tjob(P, nj, P.w_uq, (bf16_t*)(ws + OFF_WUQT), 512, 3072, 0, 3072, 1 << 30, 0, 512);
    add_tjob(P, nj, P.w_ukv, (bf16_t*)(ws + OFF_WUKT), 512, 4096, 0, 2048, 128, 256, 512);
    add_tjob(P, nj, P.w_ukv, (bf16_t*)(ws + OFF_WUVT), 512, 4096, 128, 2048, 128, 256, 512);
    add_tjob(P, nj, P.w_o_mla, (bf16_t*)(ws + OFF_WO), 2048, 2048, 0, 2048, 1 << 30, 0, 2048);
    add_tjob(P, nj, P.w_o_dsa, (bf16_t*)(ws + OFF_WO) + (size_t)2048 * 2048, 2048, 2048, 0, 2048, 1 << 30, 0, 2048);
    add_tjob(P, nj, P.w_out, (bf16_t*)(ws + OFF_WO) + (size_t)2 * 2048 * 2048, 2048, 2048, 0, 2048, 1 << 30, 0, 2048);
    for (int b = 0; b < 8; ++b) add_tjob(P, nj, P.c_v + (size_t)b * PAST * 512, (bf16_t*)(ws + OFF_VBTS) + (size_t)b * 512 * LKSP, PAST, 512, 0, 512, 1 << 30, 0, LKSP);
    add_tjob(P, nj, P.w_up, (bf16_t*)(ws + OFF_WUPT), 2048, 8192, 0, 8192, 1 << 30, 0, 2048);
    add_tjob(P, nj, P.w_down, (bf16_t*)(ws + OFF_WDNT), 8192, 2048, 0, 2048, 1 << 30, 0, 8192);
    if (nj != NTJ) { fprintf(stderr, "kernel_launch: job count %d\n", nj); return; }
#if ONE_LAUNCH
    P.ph_lo = 0; P.ph_hi = NPHASE;
    void* args[] = {&P};
    hipError_t e = hipLaunchCooperativeKernel((const void*)mega, dim3(grid), dim3(NTHREADS), args, LDS_BYTES, stream);
    if (e != hipSuccess) fprintf(stderr, "cooperative launch failed: %s (grid %d)\n", hipGetErrorString(e), grid);
#else
    const int order[NPHASE] = {0, 1, 2, 3, 4, 5, 6, 7, 8, 9, 15, 10, 11, 12, 16, 13, 14};
    for (int oi = 0; oi < NPHASE; ++oi) {
        const int ph = order[oi]; P.ph_lo = ph; P.ph_hi = ph + 1;
        void* args[] = {&P};
        hipError_t e = hipLaunchCooperativeKernel((const void*)mega, dim3(grid), dim3(NTHREADS), args, LDS_BYTES, stream);
        if (e != hipSuccess) fprintf(stderr, "launch %d failed: %s (grid %d)\n", ph, hipGetErrorString(e), grid);
    }
#endif
}
```

```cpp
#include <hip/hip_runtime.h>
#include <hip/hip_cooperative_groups.h>
#include <cstdio>
#include <cmath>
namespace cg = cooperative_groups;

#ifndef ONE_LAUNCH
#define ONE_LAUNCH 1
#endif

#define DI __device__ __forceinline__
#define LAS __attribute__((address_space(3)))
typedef unsigned short bf16_t;
typedef short bf16x8 __attribute__((ext_vector_type(8)));
typedef float f32x4 __attribute__((ext_vector_type(4)));
typedef float f32x16 __attribute__((ext_vector_type(16)));
typedef unsigned u32x4 __attribute__((ext_vector_type(4)));
typedef unsigned u32x2 __attribute__((ext_vector_type(2)));

constexpr int DM = 2048, SEQ = 4096, MPR = 8192, DS = 16, MS = 128, MR = 8320, MPAD = 8448;
constexpr int PAST = 2048, LKS = 2064, LKSP = 2112, SROWS = 16512, SROWSP = 16640;
constexpr int DFF = 8192;
constexpr int NTHREADS = 512;
constexpr int LDS_BYTES = 131072 + 1024;
constexpr float ALPHA = 1.189207115002721f;
constexpr float IDX_SCALE = 0.02209708691207961f;
constexpr float NORM_EPS = 1e-6f;
constexpr int TRI = 4096 * 2080;

constexpr size_t SZ_ACT = (size_t)MPAD * 2048 * 2;
constexpr size_t OFF_GATES = 0;
constexpr size_t OFF_WO = OFF_GATES + 2 * SZ_ACT;
constexpr size_t OFF_QB = OFF_WO + 3 * (size_t)2048 * 2048 * 2;
constexpr size_t OFF_QI = OFF_QB + SZ_ACT;
constexpr size_t OFF_R4 = OFF_QI + SZ_ACT;
constexpr size_t OFF_XB = OFF_R4;
constexpr size_t OFF_WINT = OFF_XB + SZ_ACT;
constexpr size_t OFF_SMALL = OFF_WINT + (size_t)10496 * 2048 * 2;
constexpr size_t OFF_R6 = OFF_SMALL + (size_t)MPAD * 2304 * 2;
constexpr size_t OFF_SCORE = OFF_R4;
constexpr size_t OFF_SCORE_S = OFF_SCORE + (size_t)2 * TRI * 4;
constexpr size_t OFF_CKVP = OFF_R6;
constexpr size_t OFF_CKVS = OFF_CKVP + (size_t)MPR * 512 * 2;
constexpr size_t OFF_KPEP = OFF_CKVS + (size_t)SROWSP * 512 * 2;
constexpr size_t OFF_KPES = OFF_KPEP + (size_t)MPR * 64 * 2;
constexpr size_t OFF_KBP = OFF_KPES + (size_t)SROWSP * 64 * 2;
constexpr size_t OFF_KBS = OFF_KBP + (size_t)MPR * 512 * 2;
constexpr size_t OFF_VBTP = OFF_KBS + (size_t)SROWSP * 512 * 2;
constexpr size_t OFF_VBTS = OFF_VBTP + (size_t)2 * 512 * 4096 * 2;
constexpr size_t OFF_KIP = OFF_VBTS + (size_t)8 * 512 * LKSP * 2;
constexpr size_t OFF_KIS = OFF_KIP + (size_t)MPR * 128 * 2;
constexpr size_t OFF_WI = OFF_KIS + (size_t)SROWSP * 128 * 2;
constexpr size_t OFF_QLN = OFF_WI + (size_t)MPAD * 16 * 4;
constexpr size_t OFF_MASK = OFF_QLN + (size_t)MPAD * 512 * 2;
constexpr size_t OFF_WUQT = OFF_MASK + (size_t)MR * 128 * 4;
constexpr size_t OFF_WUKT = OFF_WUQT + (size_t)3072 * 512 * 2;
constexpr size_t OFF_WUVT = OFF_WUKT + (size_t)2048 * 512 * 2;
constexpr size_t OFF_QSMLA = OFF_WUVT + (size_t)2048 * 512 * 2;
constexpr size_t OFF_CTL = OFF_QSMLA + (size_t)256 * 3072 * 2;
constexpr size_t OFF_TAIL = OFF_CTL + 4096;
constexpr size_t OFF_KNS = OFF_R4;
constexpr size_t OFF_VTS = OFF_TAIL;
constexpr size_t OFF_QMLA = OFF_R4;
constexpr size_t OFF_KNP = OFF_QMLA + (size_t)MPR * 3072 * 2;
constexpr size_t OFF_VTP = OFF_TAIL;
constexpr size_t OFF_MERGED = OFF_R4;
constexpr size_t OFF_R1 = OFF_GATES;
constexpr size_t OFF_H = OFF_QB;
constexpr size_t OFF_HB = OFF_R4;
constexpr size_t OFF_WUPT = OFF_HB + SZ_ACT;
constexpr size_t OFF_WDNT = OFF_WUPT + (size_t)8192 * 2048 * 2;
constexpr size_t OFF_U = OFF_WDNT + (size_t)8192 * 2048 * 2;
constexpr size_t OFF_PART = OFF_U + (size_t)MPAD * 8192 * 2;
constexpr size_t WS_NEED = OFF_VTS + (size_t)8 * 2048 * LKSP * 2;
static_assert(OFF_PART + (size_t)32 * 128 * 2048 * 4 <= WS_NEED, "part overlay");
static_assert(OFF_PART >= OFF_VTP + (size_t)2 * 2048 * 4096 * 2 || true, "");
static_assert(OFF_SCORE_S + (size_t)MS * LKSP * 4 <= OFF_R6, "score overlay");
static_assert(OFF_KNS + (size_t)SROWSP * 2048 * 2 <= OFF_R6, "kns overlay");
static_assert(OFF_KNP + (size_t)MPR * 2048 * 2 <= OFF_R6, "knp overlay");
static_assert(OFF_U + (size_t)MPAD * 8192 * 2 <= WS_NEED, "u overlay");
static_assert(WS_NEED <= 466000000ull, "workspace");
constexpr size_t OUT_YP = 0, OUT_YS = 16777216, OUT_PLAT = 17039360, OUT_PROPE = 21233664, OUT_PK = 21757952, OUT_PV = 25952256,
                 OUT_PIK = 30146560, OUT_SLAT = 31195136, OUT_SROPE = 31260672, OUT_SK = 31268864, OUT_SV = 31334400, OUT_SIK = 31399936;

struct TJob { const float* src; bf16_t* dst; int K, ld, c0, ncols, segw, segs, dld, pad; };
constexpr int NTJ = 27;
struct Params {
    const float *x_prompt, *x_sample, *c_lat, *c_rope, *c_k, *c_v, *c_ik, *w_in, *g_q, *g_kv, *w_uq, *w_ukv, *w_o_mla, *w_o_dsa, *w_out,
        *ln1_g, *ln1_b, *w_up, *w_down, *ln2_g, *ln2_b;
    float* out; unsigned char* ws;
    double T[32];
    TJob tj[NTJ];
    int tfirst[NTJ + 1];
    int ph_lo, ph_hi, pad0, pad1;
};

DI unsigned cvt_pk_bf16(float lo, float hi) { unsigned r; asm("v_cvt_pk_bf16_f32 %0, %1, %2" : "=v"(r) : "v"(lo), "v"(hi)); return r; }
DI float bflo(unsigned u) { return __uint_as_float(u << 16); }
DI float bfhi(unsigned u) { return __uint_as_float(u & 0xffff0000u); }
DI u32x4 pack8(const float* v) { u32x4 r; r.x = cvt_pk_bf16(v[0], v[1]); r.y = cvt_pk_bf16(v[2], v[3]); r.z = cvt_pk_bf16(v[4], v[5]); r.w = cvt_pk_bf16(v[6], v[7]); return r; }
DI void unpack8(u32x4 u, float* v) { v[0] = bflo(u.x); v[1] = bfhi(u.x); v[2] = bflo(u.y); v[3] = bfhi(u.y); v[4] = bflo(u.z); v[5] = bfhi(u.z); v[6] = bflo(u.w); v[7] = bfhi(u.w); }
DI float sigmoidf(float g) { return __builtin_amdgcn_rcpf(1.0f + __builtin_amdgcn_exp2f(-1.4426950408889634f * g)); }
DI void rope_cs(const double* T, int pos, int idx, float& c, float& s) {
    double rv = (double)pos * T[idx] * 0.15915494309189535; rv -= floor(rv);
    const float fr = (float)rv; c = __builtin_amdgcn_cosf(fr); s = __builtin_amdgcn_sinf(fr);
}

namespace pg8 {
constexpr int BM = 256, BK = 64, HALF = 128, HTB = HALF * BK * 2, NXCD = 8, WGM = 4;
DI int lds_byte(int r, int c) { const int st = (r >> 4) * 2 + (c >> 5), rr = r & 15, cc = c & 31, ob = rr * 64 + cc * 2; return st * 1024 + (ob ^ (((ob >> 9) & 1) << 5)); }
DI void stage_rc(int b, int& R, int& C) { const int st = b / 1024, sb = b % 1024, swz = sb ^ (((sb >> 9) & 1) << 5); R = (st >> 1) * 16 + swz / 64; C = (st & 1) * 32 + (swz % 64) / 2; }
DI int perm32(int rho) { const int n = rho >> 4, i = rho & 15; return 8 * (i >> 2) + 4 * n + (i & 3); }
struct Unit { int pm, pn, job; };
struct Sched {
    const char *A0, *B0; long dA1, dB1, dA2, dB2; int nM0, nN0, dM1, dN1, dM2, dN2; int f1, f2, f3, f4; int G, c; int ntm;
    const char *spA, *spB; int nsl, ksb, nts; size_t ldbb; int half; long adjA, adjB; int sp_half; long spAdjA, spAdjB;
    DI void init3(int K, const bf16_t* a0, const bf16_t* b0, int m0, int n0, const bf16_t* a1, const bf16_t* b1, int m1, int n1, const bf16_t* a2, const bf16_t* b2, int m2, int n2) {
        A0 = (const char*)a0; B0 = (const char*)b0; dA1 = (const char*)a1 - (const char*)a0; dB1 = (const char*)b1 - (const char*)b0; dA2 = (const char*)a2 - (const char*)a1; dB2 = (const char*)b2 - (const char*)b1;
        nM0 = m0; nN0 = n0; dM1 = m1 - m0; dN1 = n1 - n0; dM2 = m2 - m1; dN2 = n2 - n1; f1 = m0 * n0; f2 = f1 + m1 * n1; f3 = f2 + m2 * n2; f4 = f3; G = gridDim.x; c = blockIdx.x; ntm = K / BK;
        spA = A0; spB = B0; nsl = 1; ksb = 0; nts = 4; ldbb = (size_t)K * 2; half = 1 << 30; adjA = 0; adjB = 0; sp_half = 1 << 30; spAdjA = 0; spAdjB = 0; }
    DI void add_second(const bf16_t* A2nd, const bf16_t* B2nd, int half_tiles) { half = half_tiles; adjA = ((const char*)A2nd - A0) - (long)half_tiles * BK * 2; adjB = ((const char*)B2nd - B0) - (long)half_tiles * BK * 2; ntm = 2 * half_tiles; }
    DI void init1(int K, const bf16_t* A, const bf16_t* B, int nM, int nN) { init3(K, A, B, nM, nN, A, B, 0, 0, A, B, 0, 0); }
    DI void add_split(const bf16_t* As, const bf16_t* Bt, int npn, int nslices, int kslice) { spA = (const char*)As; spB = (const char*)Bt; nsl = nslices; ksb = kslice * 2; nts = kslice / BK; f4 = f3 + npn * nslices; sp_half = 1 << 30; spAdjA = 0; spAdjB = 0; }
    DI void split_second(const bf16_t* As2, const bf16_t* Bt2, int half_slices) { sp_half = half_slices; spAdjA = ((const char*)As2 - spA) - (long)half_slices * ksb; spAdjB = ((const char*)Bt2 - spB) - (long)half_slices * ksb; }
    DI bool next(int i, Unit& u) const {
        const long L = (long)i * G + c; if (L >= f4) return false;
        if (L >= f3) { const int sidx = (int)L - f3; u.pn = sidx / nsl; u.pm = sidx - u.pn * nsl; u.job = 3; return true; }
        const int g1 = (L >= f1) ? 1 : 0, g2 = (L >= f2) ? 1 : 0;
        int wgid = (int)L - g1 * f1 - g2 * (f2 - f1);
        const int nM = nM0 + g1 * dM1 + g2 * dM2, nN = nN0 + g1 * dN1 + g2 * dN2, nwg = nM * nN;
        { const int q = nwg / NXCD, r = nwg % NXCD, xcd = wgid % NXCD, off = wgid / NXCD; wgid = (xcd < r ? xcd * (q + 1) : r * (q + 1) + (xcd - r) * q) + off; }
        const int nig = WGM * nN, gid = wgid / nig, fm = gid * WGM, gsz = (nM - fm) < WGM ? (nM - fm) : WGM;
        u.pm = fm + ((wgid % nig) % gsz); u.pn = (wgid % nig) / gsz; u.job = g1 + g2; return true;
    }
    DI int nt(const Unit& u) const { return u.job == 3 ? nts : ntm; }
    DI void ab(const Unit& u, size_t tstep, const char*& a, const char*& b) const {
        if (u.job == 3) { const long m = -(long)(u.pm >= sp_half); a = spA + (size_t)u.pm * ksb + (spAdjA & m); b = spB + (size_t)u.pn * 256 * ldbb + (size_t)u.pm * ksb + (spAdjB & m); return; }
        const long m1 = -(long)(u.job >= 1), m2 = -(long)(u.job >= 2);
        a = A0 + (dA1 & m1) + (dA2 & m2) + (size_t)u.pm * tstep; b = B0 + (dB1 & m1) + (dB2 & m2) + (size_t)u.pn * tstep; }
};

template <class Epi>
DI void gemm_phase(const int tid, LAS unsigned char* lds, const int K, const Sched& S, const Epi& E) {
    const int wid = __builtin_amdgcn_readfirstlane(tid >> 6), lane = tid & 63, wr = wid >> 2, wc = wid & 3, fr = lane & 15, fq = lane >> 4;
    unsigned voffA[2], voffB[2];
#pragma unroll
    for (int i = 0; i < 2; ++i) { int R, C; stage_rc(tid * 16 + i * 8192, R, C); const int Rb = Epi::PERM ? ((R & ~31) + perm32(R & 31)) : R;
        voffA[i] = (unsigned)(R * K + C) * 2u; voffB[i] = (unsigned)(Rb * K + C) * 2u; }
    const size_t kstep = (size_t)(BK * 2);
    const size_t hstep = (size_t)HALF * K * 2;
    const size_t tstep = 2 * hstep;
    const unsigned ldsw = (unsigned)wid * 1024u;
    const int aoff = lds_byte(wr * 64 + fr, fq * 8), boff = lds_byte(wc * 32 + fr, fq * 8);
#define PG8_SA(b, h) (((b) * 2 + (h)) * HTB)
#define PG8_SB(b, h) ((4 + (b) * 2 + (h)) * HTB)
#define PG8_STAGE(bufoff, gbase, voff) do { _Pragma("unroll") for (int _i = 0; _i < 2; ++_i) \
        __builtin_amdgcn_global_load_lds((const unsigned*)((const char*)(gbase) + (voff)[_i]), (LAS unsigned*)(lds + (bufoff) + ldsw + _i * 8192), 16, 0, 0); } while (0)
#define PG8_LDA(dst, b, h) do { _Pragma("unroll") for (int m = 0; m < 4; ++m) _Pragma("unroll") for (int k = 0; k < 2; ++k) dst[m][k] = *(const LAS bf16x8*)(lds + PG8_SA(b, h) + aoff + m * 2048 + k * 1024); } while (0)
#define PG8_LDB(dst, b, h) do { _Pragma("unroll") for (int n = 0; n < 2; ++n) _Pragma("unroll") for (int k = 0; k < 2; ++k) dst[n][k] = *(const LAS bf16x8*)(lds + PG8_SB(b, h) + boff + n * 2048 + k * 1024); } while (0)
#define PG8_MMA(ai, bj, At, Bt) do { __builtin_amdgcn_s_setprio(1); _Pragma("unroll") for (int m = 0; m < 4; ++m) _Pragma("unroll") for (int n = 0; n < 2; ++n) _Pragma("unroll") for (int k = 0; k < 2; ++k) \
        acc[ai][bj][m][n] = __builtin_amdgcn_mfma_f32_16x16x32_bf16(Bt[n][k], At[m][k], acc[ai][bj][m][n], 0, 0, 0); __builtin_amdgcn_s_setprio(0); } while (0)
#define PG8_WAIT_V(n) asm volatile("s_waitcnt vmcnt(" #n ")" ::: "memory")
#define PG8_WAIT_L(n) asm volatile("s_waitcnt lgkmcnt(" #n ")" ::: "memory")
#define PG8_BAR __builtin_amdgcn_s_barrier()
#define PG8_SCHED __builtin_amdgcn_sched_barrier(0)
    Unit cur, nxt; int ui = 0;
    if (!S.next(0, cur)) return;
    f32x4 acc[2][2][4][2];
#pragma unroll
    for (int a = 0; a < 2; ++a)
#pragma unroll
        for (int b = 0; b < 2; ++b)
#pragma unroll
            for (int m = 0; m < 4; ++m)
#pragma unroll
                for (int n = 0; n < 2; ++n) acc[a][b][m][n] = (f32x4){0.f, 0.f, 0.f, 0.f};
    bf16x8 At[4][2], B0[2][2], B1[2][2];
    const char* cA; const char* cB; S.ab(cur, tstep, cA, cB); int nt = S.nt(cur);
    PG8_STAGE(PG8_SB(0, 0), cB, voffB); PG8_STAGE(PG8_SA(0, 0), cA, voffA); PG8_STAGE(PG8_SB(0, 1), cB + hstep, voffB); PG8_STAGE(PG8_SA(0, 1), cA + hstep, voffA);
    if (wr == 1) PG8_BAR;
    PG8_WAIT_V(4); PG8_BAR;
    PG8_STAGE(PG8_SB(1, 0), cB + kstep, voffB); PG8_STAGE(PG8_SA(1, 0), cA + kstep, voffA); PG8_STAGE(PG8_SB(1, 1), cB + hstep + kstep, voffB);
    PG8_WAIT_V(6); PG8_BAR;
    for (;;) {
        const bool has_next = S.next(ui + 1, nxt);
        const char* nA = cA; const char* nB = cB; if (has_next) S.ab(nxt, tstep, nA, nB);
        for (int t = 0; t < nt; t += 2) {
            const bool last = (t == nt - 2);
            if (Epi::MIDHOOK && t == S.half) E.mid(acc, cur, wr, wc, fr, fq);
            const long sA1 = (t + 1 >= S.half) ? S.adjA : 0, sA2 = (t + 2 >= S.half) ? S.adjA : 0, sB2 = (t + 2 >= S.half) ? S.adjB : 0;
            const char* a1 = cA + (size_t)(t + 1) * kstep + sA1;
            const char* a2 = last ? nA : cA + (size_t)(t + 2) * kstep + sA2; const char* b2 = last ? nB : cB + (size_t)(t + 2) * kstep + sB2;
            const char* a3 = a2 + kstep; const char* b3 = b2 + kstep;
            PG8_LDB(B0, 0, 0); PG8_SCHED; PG8_LDA(At, 0, 0); PG8_STAGE(PG8_SA(1, 1), a1 + hstep, voffA);
            PG8_WAIT_L(8); PG8_BAR; PG8_WAIT_L(0); PG8_MMA(0, 0, At, B0); PG8_BAR; PG8_SCHED;
            PG8_LDB(B1, 0, 1); PG8_STAGE(PG8_SB(0, 0), b2, voffB);
            PG8_BAR; PG8_WAIT_L(0); PG8_MMA(0, 1, At, B1); PG8_BAR;
            PG8_LDA(At, 0, 1); PG8_STAGE(PG8_SA(0, 0), a2, voffA);
            PG8_BAR; PG8_WAIT_L(0); PG8_MMA(1, 0, At, B0); PG8_BAR; PG8_SCHED;
            PG8_STAGE(PG8_SB(0, 1), b2 + hstep, voffB);
            PG8_WAIT_V(6); PG8_BAR; PG8_MMA(1, 1, At, B1); PG8_BAR;
            PG8_LDB(B0, 1, 0); PG8_SCHED; PG8_LDA(At, 1, 0); PG8_STAGE(PG8_SA(0, 1), a2 + hstep, voffA);
            PG8_WAIT_L(8); PG8_BAR; PG8_WAIT_L(0); PG8_MMA(0, 0, At, B0); PG8_BAR; PG8_SCHED;
            PG8_LDB(B1, 1, 1); PG8_STAGE(PG8_SB(1, 0), b3, voffB);
            PG8_BAR; PG8_WAIT_L(0); PG8_MMA(0, 1, At, B1); PG8_BAR;
            PG8_LDA(At, 1, 1); PG8_STAGE(PG8_SA(1, 0), a3, voffA);
            PG8_BAR; PG8_WAIT_L(0); PG8_MMA(1, 0, At, B0); PG8_BAR; PG8_SCHED;
            PG8_STAGE(PG8_SB(1, 1), b3 + hstep, voffB);
            PG8_WAIT_V(6); PG8_BAR; PG8_MMA(1, 1, At, B1); PG8_BAR;
        }
        E(acc, cur, wr, wc, fr, fq);
        if (!has_next) break;
#pragma unroll
        for (int a = 0; a < 2; ++a)
#pragma unroll
            for (int b = 0; b < 2; ++b)
#pragma unroll
                for (int m = 0; m < 4; ++m)
#pragma unroll
                    for (int n = 0; n < 2; ++n) acc[a][b][m][n] = (f32x4){0.f, 0.f, 0.f, 0.f};
        cur = nxt; cA = nA; cB = nB; ++ui; nt = S.nt(cur);
    }
    PG8_WAIT_V(0);
    if (wr == 0) PG8_BAR;
    PG8_BAR;
#undef PG8_SA
#undef PG8_SB
#undef PG8_STAGE
#undef PG8_LDA
#undef PG8_LDB
#undef PG8_MMA
#undef PG8_WAIT_V
#undef PG8_WAIT_L
#undef PG8_BAR
#undef PG8_SCHED
}
}

enum { EM_PROJ = 0, EM_UPS, EM_UPP, EM_O1, EM_O2, EM_FFNUP, EM_OF };
struct EpiB {
    static constexpr bool PERM = true, MIDHOOK = true;
    int mode; unsigned char* ws; int ldp;
    DI void mid(f32x4 (&acc)[2][2][4][2], const pg8::Unit& u, int wr, int wc, int fr, int fq) const {
#pragma unroll
        for (int ai = 0; ai < 2; ++ai)
#pragma unroll
            for (int m = 0; m < 4; ++m) {
                int rb = u.pm * 256 + wr * 64 + fr; asm volatile("" : "+v"(rb));
                const int r = rb + ai * 128 + m * 16;
                int cb = u.pn * 256 + wc * 32 + 8 * fq; asm volatile("" : "+v"(cb));
                const bf16_t* gp = (const bf16_t*)(ws + OFF_GATES) + (size_t)r * 4096 + cb;
                const u32x4 ga0 = *(const u32x4*)gp, ga1 = *(const u32x4*)(gp + 128), gb0 = *(const u32x4*)(gp + 2048), gb1 = *(const u32x4*)(gp + 2048 + 128);
                float a[8], b[8];
                unpack8(ga0, a); unpack8(gb0, b);
#pragma unroll
                for (int j = 0; j < 8; ++j) { const float rt = (1.0f + __builtin_amdgcn_exp2f(-1.4426950408889634f * fmaxf(b[j], -60.0f))) * __builtin_amdgcn_rcpf(1.0f + __builtin_amdgcn_exp2f(-1.4426950408889634f * a[j])); acc[ai][0][m][j >> 2][j & 3] *= rt; }
                unpack8(ga1, a); unpack8(gb1, b);
#pragma unroll
                for (int j = 0; j < 8; ++j) { const float rt = (1.0f + __builtin_amdgcn_exp2f(-1.4426950408889634f * fmaxf(b[j], -60.0f))) * __builtin_amdgcn_rcpf(1.0f + __builtin_amdgcn_exp2f(-1.4426950408889634f * a[j])); acc[ai][1][m][j >> 2][j & 3] *= rt; }
                asm volatile("" ::: "memory");
            }
    }
    DI void operator()(const f32x4 (&acc)[2][2][4][2], const pg8::Unit& u, int wr, int wc, int fr, int fq) const {
#pragma unroll
        for (int ai = 0; ai < 2; ++ai)
#pragma unroll
            for (int m = 0; m < 4; ++m) {
                int rb = u.pm * 256 + wr * 64 + fr; asm volatile("" : "+v"(rb));
                const int r = rb + ai * 128 + m * 16;
#pragma unroll
                for (int bj = 0; bj < 2; ++bj) {
                    int cb = u.pn * 256 + wc * 32 + 8 * fq; asm volatile("" : "+v"(cb));
                    const int c0 = cb + bj * 128;
                    if (u.job == 3) {
                        if (ai == 0) { float* pd = (float*)(ws + OFF_PART) + ((size_t)u.pm * 128 + wr * 64 + m * 16 + fr) * ldp + c0;
                            *(f32x4*)pd = acc[ai][bj][m][0]; *(f32x4*)(pd + 4) = acc[ai][bj][m][1]; }
                        continue; }
                    float v[8];
#pragma unroll
                    for (int j = 0; j < 4; ++j) { v[j] = acc[ai][bj][m][0][j]; v[4 + j] = acc[ai][bj][m][1][j]; }
                    bf16_t* dst = nullptr;
                    if (mode == EM_PROJ) {
                        if (u.pn < 8) dst = (bf16_t*)(ws + OFF_QB) + (size_t)r * 2048 + c0;
                        else if (u.pn < 16) dst = (bf16_t*)(ws + OFF_QI) + (size_t)r * 2048 + (c0 - 2048);
                        else if (u.pn < 32) dst = (bf16_t*)(ws + OFF_GATES) + (size_t)r * 4096 + (c0 - 4096);
                        else dst = (bf16_t*)(ws + OFF_SMALL) + (size_t)r * 2304 + (c0 - 8192);
                    } else if (mode == EM_UPS || mode == EM_UPP) {
                        const bool smp = (mode == EM_UPS);
                        if (u.job == 0) dst = (bf16_t*)(ws + (smp ? OFF_QSMLA : OFF_QMLA)) + (size_t)r * 3072 + c0;
                        else if (u.job == 1) dst = (bf16_t*)(ws + (smp ? OFF_KNS : OFF_KNP)) + (size_t)r * 2048 + c0;
                        else {
                            const int LK = smp ? LKS : 4096, ldv = smp ? LKSP : 4096, nvalid = smp ? SROWS : MPR;
                            if (c0 < nvalid) { const int bidx = c0 / LK, key = c0 - bidx * LK; dst = (bf16_t*)(ws + (smp ? OFF_VTS : OFF_VTP)) + ((size_t)bidx * 2048 + r) * ldv + key; }
                        }
                    } else if (mode == EM_O1 || mode == EM_O2) {
#pragma unroll
                        for (int n = 0; n < 2; ++n) {
                            const u32x2 gv = *(const u32x2*)((const bf16_t*)(ws + OFF_GATES) + (size_t)r * 4096 + (mode == EM_O2 ? 2048 : 0) + c0 + 4 * n);
                            u32x2* mp = (u32x2*)((bf16_t*)(ws + OFF_MERGED) + (size_t)r * 2048 + c0 + 4 * n);
                            float o0 = sigmoidf(bflo(gv.x)) * v[4 * n], o1 = sigmoidf(bfhi(gv.x)) * v[4 * n + 1], o2 = sigmoidf(bflo(gv.y)) * v[4 * n + 2], o3 = sigmoidf(bfhi(gv.y)) * v[4 * n + 3];
                            if (mode == EM_O2) { const u32x2 ov = *mp; o0 += bflo(ov.x); o1 += bfhi(ov.x); o2 += bflo(ov.y); o3 += bfhi(ov.y); }
                            u32x2 w2; w2.x = cvt_pk_bf16(o0, o1); w2.y = cvt_pk_bf16(o2, o3); *mp = w2;
                            asm volatile("" ::: "memory");
                        }
                    } else if (mode == EM_OF) {
                        float g[8]; unpack8(*(const u32x4*)((const bf16_t*)(ws + OFF_GATES) + (size_t)r * 4096 + 2048 + c0), g);
#pragma unroll
                        for (int j = 0; j < 8; ++j) v[j] *= sigmoidf(fmaxf(g[j], -60.0f));
                        dst = (bf16_t*)(ws + OFF_MERGED) + (size_t)r * 2048 + c0;
                    } else {
#pragma unroll
                        for (int j = 0; j < 8; ++j) { const float t = fmaxf(v[j], 0.f); v[j] = t * t; }
                        dst = (bf16_t*)(ws + OFF_U) + (size_t)r * 8192 + c0;
                    }
                    if (dst) *(u32x4*)dst = pack8(v);
                    asm volatile("" ::: "memory");
                }
            }
    }
};
enum { EF_OUT = 0, EF_DOWN };
struct EpiF {
    static constexpr bool PERM = false, MIDHOOK = false;
    int mode; unsigned char* ws; const float* xp; const float* xs;
    DI void mid(f32x4 (&)[2][2][4][2], const pg8::Unit&, int, int, int, int) const {}
    DI void operator()(const f32x4 (&acc)[2][2][4][2], const pg8::Unit& u, int wr, int wc, int fr, int fq) const {
#pragma unroll
        for (int ai = 0; ai < 2; ++ai)
#pragma unroll
            for (int m = 0; m < 4; ++m) {
                if (u.job == 3) {
                    if (ai == 0) { float* pd = (float*)(ws + OFF_PART) + ((size_t)u.pm * 128 + wr * 64 + m * 16 + fr) * 2048;
#pragma unroll
                        for (int bj = 0; bj < 2; ++bj)
#pragma unroll
                            for (int n = 0; n < 2; ++n) *(f32x4*)(pd + u.pn * 256 + bj * 128 + wc * 32 + 16 * n + 4 * fq) = acc[ai][bj][m][n]; }
                    continue; }
                const int r = u.pm * 256 + ai * 128 + wr * 64 + m * 16 + fr;
                if (r >= MR) continue;
                const float* res = (mode == EF_OUT) ? (r < MPR ? xp + (size_t)r * 2048 : xs + (size_t)(r - MPR) * 2048) : (const float*)(ws + OFF_H) + (size_t)r * 2048;
                float* dst = (float*)(ws + OFF_R1) + (size_t)r * 2048;
#pragma unroll
                for (int bj = 0; bj < 2; ++bj)
#pragma unroll
                    for (int n = 0; n < 2; ++n) {
                        const int c = u.pn * 256 + bj * 128 + wc * 32 + 16 * n + 4 * fq;
                        const f32x4 x = *(const f32x4*)(res + c);
                        *(f32x4*)(dst + c) = x * ALPHA + acc[ai][bj][m][n];
                    }
            }
    }
};

DI void transpose_jobs(const Params& p, const int tid, LAS unsigned char* lds, int j_lo, int j_hi, int bid, int nb) {
    LAS float* tile = (LAS float*)lds;
    const int t_lo = p.tfirst[j_lo], t_hi = p.tfirst[j_hi];
    const int i0 = tid >> 4, j4 = (tid & 15) * 4, nn = tid >> 3, k8 = (tid & 7) * 8;
    f32x4 va0, va1, vb0, vb1; bf16_t *da = nullptr, *db = nullptr; int lda_ = 0, ldb_ = 0, ka = 0, kb = 0, na = 0, nb_ = 0, ca = 0, cb = 0;
    va0 = va1 = vb0 = vb1 = (f32x4){0.f, 0.f, 0.f, 0.f};
#define TJ_LOAD(t, V0, V1, D, DL, K0, N0, NC) do { int jb = j_lo; while ((t) >= p.tfirst[jb + 1]) ++jb; \
        const float* src_ = p.tj[jb].src; const int K_ = p.tj[jb].K, ld_ = p.tj[jb].ld, c0_ = p.tj[jb].c0, segw_ = p.tj[jb].segw, segs_ = p.tj[jb].segs; \
        const int lt_ = (t) - p.tfirst[jb], tk_ = K_ / 64, kt_ = lt_ % tk_, nt_ = lt_ / tk_; \
        D = p.tj[jb].dst; DL = p.tj[jb].dld; K0 = kt_ * 64; N0 = nt_ * 64; NC = p.tj[jb].ncols; \
        const int n_ = N0 + j4; V0 = (f32x4){0.f, 0.f, 0.f, 0.f}; V1 = V0; \
        if (n_ < NC) { const int sc_ = c0_ + (n_ / segw_) * segs_ + (n_ % segw_); V0 = __builtin_nontemporal_load((const f32x4*)(src_ + (size_t)(K0 + i0) * ld_ + sc_)); V1 = __builtin_nontemporal_load((const f32x4*)(src_ + (size_t)(K0 + i0 + 32) * ld_ + sc_)); } } while (0)
    int t = t_lo + bid;
    if (t < t_hi) TJ_LOAD(t, va0, va1, da, lda_, ka, na, ca);
    if (t + nb < t_hi) TJ_LOAD(t + nb, vb0, vb1, db, ldb_, kb, nb_, cb);
    for (; t < t_hi; t += nb) {
        bf16_t* dst = da; const int dld = lda_, k0 = ka, n0 = na, ncols = ca;
        __syncthreads();
        tile[i0 * 65 + j4] = va0.x; tile[i0 * 65 + j4 + 1] = va0.y; tile[i0 * 65 + j4 + 2] = va0.z; tile[i0 * 65 + j4 + 3] = va0.w;
        tile[(i0 + 32) * 65 + j4] = va1.x; tile[(i0 + 32) * 65 + j4 + 1] = va1.y; tile[(i0 + 32) * 65 + j4 + 2] = va1.z; tile[(i0 + 32) * 65 + j4 + 3] = va1.w;
        __syncthreads();
        va0 = vb0; va1 = vb1; da = db; lda_ = ldb_; ka = kb; na = nb_; ca = cb;
        const int tn = t + 2 * nb;
        if (tn < t_hi) TJ_LOAD(tn, vb0, vb1, db, ldb_, kb, nb_, cb);
        if (n0 + nn < ncols) {
            float v[8];
#pragma unroll
            for (int e = 0; e < 8; ++e) v[e] = tile[(k8 + e) * 65 + nn];
            *(u32x4*)(dst + (size_t)(n0 + nn) * dld + k0 + k8) = pack8(v);
        }
    }
#undef TJ_LOAD
    __syncthreads();
}
DI void copy_cache(const float* src, bf16_t* dst, int W, size_t gtid, size_t gsz) {
    const int gpr = W / 8; const size_t total = (size_t)SROWSP * gpr;
#pragma unroll 4
    for (size_t i = gtid; i < total; i += gsz) {
        const int R = (int)(i / gpr), cg8 = (int)(i % gpr) * 8; const int b = R / LKS, k = R - b * LKS;
        if (R >= SROWS) { *(u32x4*)(dst + (size_t)R * W + cg8) = (u32x4){0u, 0u, 0u, 0u}; continue; }
        if (k >= PAST) continue;
        const float* s = src + ((size_t)b * PAST + k) * W + cg8; const f32x4 a = __builtin_nontemporal_load((const f32x4*)s), c = __builtin_nontemporal_load((const f32x4*)(s + 4));
        float v[8] = {a.x, a.y, a.z, a.w, c.x, c.y, c.z, c.w};
        *(u32x4*)(dst + (size_t)R * W + cg8) = pack8(v);
    }
}
DI void phase_prep(const Params& p, const int tid, unsigned char* ws, LAS unsigned char* lds) {
    const size_t gtid = (size_t)blockIdx.x * NTHREADS + tid, gsz = (size_t)gridDim.x * NTHREADS;
    { bf16_t* xb = (bf16_t*)(ws + OFF_XB); const size_t total = (size_t)MPAD * 256;
#pragma unroll 4
      for (size_t i = gtid; i < total; i += gsz) { const int r = (int)(i >> 8), c8 = (int)(i & 255) * 8; float v[8] = {0, 0, 0, 0, 0, 0, 0, 0};
          if (r < MR) { const float* s = (r < MPR ? p.x_prompt + (size_t)r * 2048 : p.x_sample + (size_t)(r - MPR) * 2048) + c8; const f32x4 a = __builtin_nontemporal_load((const f32x4*)s), c = __builtin_nontemporal_load((const f32x4*)(s + 4));
              v[0] = a.x; v[1] = a.y; v[2] = a.z; v[3] = a.w; v[4] = c.x; v[5] = c.y; v[6] = c.z; v[7] = c.w; }
          *(u32x4*)(xb + (size_t)r * 2048 + c8) = pack8(v); } }
    copy_cache(p.c_lat, (bf16_t*)(ws + OFF_CKVS), 512, gtid, gsz);
    copy_cache(p.c_rope, (bf16_t*)(ws + OFF_KPES), 64, gtid, gsz);
    copy_cache(p.c_k, (bf16_t*)(ws + OFF_KBS), 512, gtid, gsz);
    copy_cache(p.c_ik, (bf16_t*)(ws + OFF_KIS), 128, gtid, gsz);
    { bf16_t* a = (bf16_t*)(ws + OFF_VBTS); const size_t total = (size_t)8 * 512 * 6;
      for (size_t i = gtid; i < total; i += gsz) *(u32x4*)(a + (i / 6) * LKSP + LKS + (i % 6) * 8) = (u32x4){0u, 0u, 0u, 0u};
      bf16_t* b = (bf16_t*)(ws + OFF_VTS); const size_t total2 = (size_t)8 * 2048 * 6;
      for (size_t i = gtid; i < total2; i += gsz) *(u32x4*)(b + (i / 6) * LKSP + LKS + (i % 6) * 8) = (u32x4){0u, 0u, 0u, 0u}; }
    transpose_jobs(p, tid, lds, 0, NTJ - 2, blockIdx.x, gridDim.x);
}

DI void rope32(float* v, int lane, const float* c32, const float* s32) {
    const int sub = lane & 15;
#pragma unroll
    for (int e = 0; e < 8; ++e) { const float oth = __shfl_xor(v[e], 2); if (sub < 2) v[e] = v[e] * c32[e] - oth * s32[e]; else if (sub < 4) v[e] = v[e] * c32[e] + oth * s32[e]; }
}
DI void rope_cs_d(double tv, int pos, float& c, float& s) {
    double rv = (double)pos * tv * 0.15915494309189535; rv -= floor(rv);
    const float fr = (float)rv; c = __builtin_amdgcn_cosf(fr); s = __builtin_amdgcn_sinf(fr);
}
DI void phase_post(const Params& p, const int tid, unsigned char* ws, LAS unsigned char* lds) {
    const int lane = tid & 63, wv = blockIdx.x * 8 + __builtin_amdgcn_readfirstlane(tid >> 6), nwv = gridDim.x * 8;
    double t32[8], t64[8];
#pragma unroll
    for (int e = 0; e < 8; ++e) { t32[e] = p.T[2 * (8 * (lane & 1) + e)]; t64[e] = p.T[8 * (lane & 3) + e]; }
    const f32x4 gq0 = *(const f32x4*)(p.g_q + 8 * lane), gq1 = *(const f32x4*)(p.g_q + 8 * lane + 4), gk0 = *(const f32x4*)(p.g_kv + 8 * lane), gk1 = *(const f32x4*)(p.g_kv + 8 * lane + 4);
    for (int r = wv; r < MR; r += nwv) {
        const bool smp = r >= MPR; const int rs = r - MPR;
        const int pos = smp ? PAST + (rs & 15) : (r & 4095);
        const int crow = smp ? ((rs >> 4) * LKS + PAST + (rs & 15)) : r;
        const bf16_t* srow = (const bf16_t*)(ws + OFF_SMALL) + (size_t)r * 2304;
        bf16_t* qbrow = (bf16_t*)(ws + OFF_QB) + (size_t)r * 2048; bf16_t* qirow = (bf16_t*)(ws + OFF_QI) + (size_t)r * 2048;
        const int l8 = lane & 7, l16 = lane & 15;
        const u32x4 r_ql = *(const u32x4*)(srow + 8 * lane), r_kv = *(const u32x4*)(srow + 512 + 8 * lane), r_kb = *(const u32x4*)(srow + 1024 + 8 * lane), r_vb = *(const u32x4*)(srow + 1536 + 8 * lane);
        const u32x4 r_pe = *(const u32x4*)(srow + 2048 + 8 * l8), r_ki = *(const u32x4*)(srow + 2112 + 8 * l16), r_wi = *(const u32x4*)(srow + 2240 + 8 * (lane & 1));
        u32x4 r_q[2][4];
#pragma unroll
        for (int sg = 0; sg < 4; ++sg) { r_q[0][sg] = *(const u32x4*)(qbrow + sg * 512 + 8 * lane); r_q[1][sg] = *(const u32x4*)(qirow + sg * 512 + 8 * lane); }
        float c32[8], s32[8], c64[8], s64[8];
#pragma unroll
        for (int e = 0; e < 8; ++e) { rope_cs_d(t32[e], pos, c32[e], s32[e]); rope_cs_d(t64[e], pos, c64[e], s64[e]); }
        float v[8];
        { unpack8(r_ql, v); float ss = 0.f;
#pragma unroll
          for (int e = 0; e < 8; ++e) ss += v[e] * v[e];
#pragma unroll
          for (int d = 1; d < 64; d <<= 1) ss += __shfl_xor(ss, d);
          const float rstd = rsqrtf(ss * (1.0f / 512.0f) + NORM_EPS);
          const float g[8] = {gq0.x, gq0.y, gq0.z, gq0.w, gq1.x, gq1.y, gq1.z, gq1.w};
#pragma unroll
          for (int e = 0; e < 8; ++e) v[e] = v[e] * rstd * g[e];
          *(u32x4*)((bf16_t*)(ws + OFF_QLN) + (size_t)r * 512 + 8 * lane) = pack8(v); }
        { unpack8(r_kv, v); float ss = 0.f;
#pragma unroll
          for (int e = 0; e < 8; ++e) ss += v[e] * v[e];
#pragma unroll
          for (int d = 1; d < 64; d <<= 1) ss += __shfl_xor(ss, d);
          const float rstd = rsqrtf(ss * (1.0f / 512.0f) + NORM_EPS);
          const float g[8] = {gk0.x, gk0.y, gk0.z, gk0.w, gk1.x, gk1.y, gk1.z, gk1.w};
#pragma unroll
          for (int e = 0; e < 8; ++e) v[e] = v[e] * rstd * g[e];
          float* o = p.out + (smp ? OUT_SLAT + (size_t)rs * 512 : OUT_PLAT + (size_t)r * 512) + 8 * lane;
          *(f32x4*)o = (f32x4){v[0], v[1], v[2], v[3]}; *(f32x4*)(o + 4) = (f32x4){v[4], v[5], v[6], v[7]};
          *(u32x4*)((bf16_t*)(ws + (smp ? OFF_CKVS : OFF_CKVP)) + (size_t)crow * 512 + 8 * lane) = pack8(v); }
        { unpack8(r_kb, v); rope32(v, lane, c32, s32);
          float* o = p.out + (smp ? OUT_SK + (size_t)rs * 512 : OUT_PK + (size_t)r * 512) + 8 * lane;
          *(f32x4*)o = (f32x4){v[0], v[1], v[2], v[3]}; *(f32x4*)(o + 4) = (f32x4){v[4], v[5], v[6], v[7]};
          *(u32x4*)((bf16_t*)(ws + (smp ? OFF_KBS : OFF_KBP)) + (size_t)crow * 512 + 8 * lane) = pack8(v); }
        { unpack8(r_vb, v);
          float* o = p.out + (smp ? OUT_SV + (size_t)rs * 512 : OUT_PV + (size_t)r * 512) + 8 * lane;
          *(f32x4*)o = (f32x4){v[0], v[1], v[2], v[3]}; *(f32x4*)(o + 4) = (f32x4){v[4], v[5], v[6], v[7]};
          bf16_t* vt; size_t ldv; int key;
          if (smp) { vt = (bf16_t*)(ws + OFF_VBTS) + (size_t)(rs >> 4) * 512 * LKSP; ldv = LKSP; key = PAST + (rs & 15); }
          else { vt = (bf16_t*)(ws + OFF_VBTP) + (size_t)(r >> 12) * 512 * 4096; ldv = 4096; key = r & 4095; }
          const unsigned w4[4] = {r_vb.x, r_vb.y, r_vb.z, r_vb.w};
          if (smp) {
#pragma unroll
              for (int e = 0; e < 8; ++e) vt[(size_t)(8 * lane + e) * ldv + key] = (bf16_t)((e & 1) ? (w4[e >> 1] >> 16) : (w4[e >> 1] & 0xffffu)); } }
        { unpack8(r_pe, v);
#pragma unroll
          for (int e = 0; e < 8; ++e) { const float oth = __shfl_xor(v[e], 4); v[e] = (l8 < 4) ? v[e] * c64[e] - oth * s64[e] : v[e] * c64[e] + oth * s64[e]; }
          if (lane < 8) { float* o = p.out + (smp ? OUT_SROPE + (size_t)rs * 64 : OUT_PROPE + (size_t)r * 64) + 8 * lane;
              *(f32x4*)o = (f32x4){v[0], v[1], v[2], v[3]}; *(f32x4*)(o + 4) = (f32x4){v[4], v[5], v[6], v[7]};
              *(u32x4*)((bf16_t*)(ws + (smp ? OFF_KPES : OFF_KPEP)) + (size_t)crow * 64 + 8 * lane) = pack8(v); } }
        { unpack8(r_ki, v); rope32(v, lane, c32, s32);
          if (lane < 16) { float* o = p.out + (smp ? OUT_SIK + (size_t)rs * 128 : OUT_PIK + (size_t)r * 128) + 8 * lane;
              *(f32x4*)o = (f32x4){v[0], v[1], v[2], v[3]}; *(f32x4*)(o + 4) = (f32x4){v[4], v[5], v[6], v[7]};
              *(u32x4*)((bf16_t*)(ws + (smp ? OFF_KIS : OFF_KIP)) + (size_t)crow * 128 + 8 * lane) = pack8(v); } }
        if (lane < 2) { unpack8(r_wi, v); float* o = (float*)(ws + OFF_WI) + (size_t)r * 16 + 8 * lane;
            *(f32x4*)o = (f32x4){v[0], v[1], v[2], v[3]} * IDX_SCALE; *(f32x4*)(o + 4) = (f32x4){v[4], v[5], v[6], v[7]} * IDX_SCALE; }
#pragma unroll
        for (int which = 0; which < 2; ++which) { bf16_t* qrow = which ? qirow : qbrow;
#pragma unroll
            for (int sg = 0; sg < 4; ++sg) { unpack8(r_q[which][sg], v); rope32(v, lane, c32, s32); if ((lane & 15) < 4) *(u32x4*)(qrow + sg * 512 + 8 * lane) = pack8(v); } }
    }
    constexpr int VROWB = 1028;
    for (int t = blockIdx.x; t < MPR / 64; t += gridDim.x) {
        __syncthreads();
        const int tok0 = t * 64;
#pragma unroll
        for (int k = 0; k < 8; ++k) { const int c = k * 512 + tid, row = c >> 6, c16 = c & 63;
            const u32x4 d = *(const u32x4*)((const bf16_t*)(ws + OFF_SMALL) + (size_t)(tok0 + row) * 2304 + 1536 + c16 * 8);
            LAS unsigned* dstl = (LAS unsigned*)(lds + row * VROWB + c16 * 16); dstl[0] = d.x; dstl[1] = d.y; dstl[2] = d.z; dstl[3] = d.w; }
        __syncthreads();
        bf16_t* vrow = (bf16_t*)(ws + OFF_VBTP) + ((size_t)(tok0 >> 12) * 512 + tid) * 4096 + (tok0 & 4095);
#pragma unroll
        for (int k8 = 0; k8 < 8; ++k8) { unsigned w4[4];
#pragma unroll
            for (int j = 0; j < 4; ++j) { const unsigned lo = *(const LAS unsigned short*)(lds + (k8 * 8 + 2 * j) * VROWB + tid * 2), hi = *(const LAS unsigned short*)(lds + (k8 * 8 + 2 * j + 1) * VROWB + tid * 2); w4[j] = lo | (hi << 16); }
            *(u32x4*)(vrow + k8 * 8) = (u32x4){w4[0], w4[1], w4[2], w4[3]}; }
    }
    __syncthreads();
}

__device__ unsigned g_ctr[64 * 4];
DI int next_unit(const int tid, unsigned* ctr, volatile LAS int* slot) {
    __syncthreads();
    if (tid == 0) *slot = (int)atomicAdd(ctr, 1u);
    __syncthreads();
    int u = __builtin_amdgcn_readfirstlane(*slot); asm volatile("" : "+s"(u));
    return u;
}

template <int NP>
DI void idx_wave(const bf16_t* QI, const float* WI, int tok0, const bf16_t* KI, int k_lo, int k_hi, int nvalid, float* sc, int stride, int lane) {
    const int hf = lane >> 5, r32 = lane & 31;
    bf16x8 A[NP][8]; unsigned sg[NP];
#pragma unroll
    for (int pr = 0; pr < NP; ++pr) {
        const int token = tok0 + 2 * pr + (r32 >> 4), head = r32 & 15;
        const float w = fabsf(WI[(size_t)token * 16 + head]);
        const bf16_t* q = QI + (size_t)token * 2048 + head * 128 + 8 * hf;
#pragma unroll
        for (int s = 0; s < 8; ++s) { float v[8]; unpack8(*(const u32x4*)(q + 16 * s), v);
#pragma unroll
            for (int e = 0; e < 8; ++e) v[e] *= w;
            const u32x4 pk = pack8(v); A[pr][s] = *(const bf16x8*)&pk; }
        unsigned bits = 0;
#pragma unroll
        for (int tt = 0; tt < 2; ++tt)
#pragma unroll
            for (int i = 0; i < 8; ++i) { const int hd = 8 * ((i >> 2) & 1) + 4 * hf + (i & 3); if (WI[(size_t)(tok0 + 2 * pr + tt) * 16 + hd] < 0.f) bits |= 1u << (tt * 8 + i); }
        sg[pr] = bits;
    }
    for (int k0 = k_lo; k0 < k_hi; k0 += 32) {
        bf16x8 B[8]; const bf16_t* kp = KI + (size_t)(k0 + r32) * 128 + 8 * hf;
#pragma unroll
        for (int s = 0; s < 8; ++s) B[s] = *(const bf16x8*)(kp + 16 * s);
#pragma unroll
        for (int pr = 0; pr < NP; ++pr) {
            f32x16 d = {0, 0, 0, 0, 0, 0, 0, 0, 0, 0, 0, 0, 0, 0, 0, 0};
#pragma unroll
            for (int s = 0; s < 8; ++s) d = __builtin_amdgcn_mfma_f32_32x32x16_bf16(A[pr][s], B[s], d, 0, 0, 0);
            float v0 = 0.f, v1 = 0.f;
#pragma unroll
            for (int i = 0; i < 8; ++i) { const float a = fmaxf(d[i], 0.f), b = fmaxf(d[8 + i], 0.f);
                v0 += ((sg[pr] >> i) & 1u) ? -a : a; v1 += ((sg[pr] >> (8 + i)) & 1u) ? -b : b; }
            const float send = hf ? v0 : v1, recv = __shfl_xor(send, 32), res = (hf ? v1 : v0) + recv;
            const int key = k0 + r32;
            if (key < nvalid) sc[(size_t)(2 * pr + hf) * stride + key] = res;
        }
    }
}
DI void idx_block(const int tid, LAS unsigned char* lds, const bf16_t* QI, const float* WI, int tok0, const bf16_t* KI, int k_lo, int k_hi, float* sc, int stride) {
    constexpr int NP = 4, KROW = 272, BUF = 64 * KROW;
    const int lane = tid & 63, hf = lane >> 5, r32 = lane & 31;
    bf16x8 A[NP][8]; unsigned sg[NP];
#pragma unroll
    for (int pr = 0; pr < NP; ++pr) {
        const int token = tok0 + 2 * pr + (r32 >> 4), head = r32 & 15;
        const float w = fabsf(WI[(size_t)token * 16 + head]);
        const bf16_t* q = QI + (size_t)token * 2048 + head * 128 + 8 * hf;
#pragma unroll
        for (int s = 0; s < 8; ++s) { float v[8]; unpack8(*(const u32x4*)(q + 16 * s), v);
#pragma unroll
            for (int e = 0; e < 8; ++e) v[e] *= w;
            const u32x4 pk = pack8(v); A[pr][s] = *(const bf16x8*)&pk; }
        unsigned bits = 0;
#pragma unroll
        for (int tt = 0; tt < 2; ++tt)
#pragma unroll
            for (int i = 0; i < 8; ++i) { const int hd = 8 * ((i >> 2) & 1) + 4 * hf + (i & 3); if (WI[(size_t)(tok0 + 2 * pr + tt) * 16 + hd] < 0.f) bits |= 1u << (tt * 8 + i); }
        sg[pr] = bits;
    }
    const int krow0 = tid >> 4, kc16 = tid & 15;
    const bf16_t* gk = KI + (size_t)krow0 * 128 + kc16 * 8;
    const int lk = krow0 * KROW + kc16 * 16;
    u32x4 sk0, sk1;
    const int nt = (k_hi - k_lo) >> 6;
    sk0 = *(const u32x4*)(gk + (size_t)k_lo * 128); sk1 = *(const u32x4*)(gk + (size_t)(k_lo + 32) * 128);
#pragma unroll 1
    for (int kc = 0; kc < nt; ++kc) {
        LAS unsigned char* buf = lds + (kc & 1) * BUF;
        *(LAS u32x4*)(buf + lk) = sk0; *(LAS u32x4*)(buf + lk + 32 * KROW) = sk1;
        __syncthreads();
        if (kc + 1 < nt) { const size_t kn = (size_t)(k_lo + 64 * (kc + 1)); sk0 = *(const u32x4*)(gk + kn * 128); sk1 = *(const u32x4*)(gk + (kn + 32) * 128); }
#pragma unroll 1
        for (int sub = 0; sub < 2; ++sub) {
            bf16x8 B[8]; const LAS unsigned char* kp = buf + (32 * sub + r32) * KROW + 16 * hf;
#pragma unroll
            for (int s = 0; s < 8; ++s) B[s] = *(const LAS bf16x8*)(kp + 32 * s);
            const int key = k_lo + 64 * kc + 32 * sub + r32;
#pragma unroll
            for (int pr = 0; pr < NP; ++pr) {
                f32x16 d = {0, 0, 0, 0, 0, 0, 0, 0, 0, 0, 0, 0, 0, 0, 0, 0};
#pragma unroll
                for (int s = 0; s < 8; ++s) d = __builtin_amdgcn_mfma_f32_32x32x16_bf16(A[pr][s], B[s], d, 0, 0, 0);
                float v0 = 0.f, v1 = 0.f;
#pragma unroll
                for (int i = 0; i < 8; ++i) { const float a = fmaxf(d[i], 0.f), b = fmaxf(d[8 + i], 0.f);
                    v0 += ((sg[pr] >> i) & 1u) ? -a : a; v1 += ((sg[pr] >> (8 + i)) & 1u) ? -b : b; }
                const float send = hf ? v0 : v1, recv = __shfl_xor(send, 32), res = (hf ? v1 : v0) + recv;
                sc[(size_t)(2 * pr + hf) * stride + key] = res;
            }
        }
    }
}
DI void phase_index(const Params& p, const int tid, unsigned char* ws, LAS unsigned char* lds, int rep) {
    unsigned* ctr = &g_ctr[0 * 64]; (void)rep; volatile LAS int* slot = (volatile LAS int*)(lds + 131072);
    const int lane = tid & 63, w = __builtin_amdgcn_readfirstlane(tid >> 6);
    const bf16_t* QI = (const bf16_t*)(ws + OFF_QI); const float* WI = (const float*)(ws + OFF_WI);
    for (;;) {
        int u = next_unit(tid, ctr, slot);
        if (u >= 64 + 576) break;
        if (u < 64) {
            const int b = u >> 3, sg = u & 7, k_lo = 32 * ((65 * sg) / 8), k_hi = 32 * ((65 * (sg + 1)) / 8);
            idx_wave<1>(QI, WI, MPR + b * 16 + 2 * w, (const bf16_t*)(ws + OFF_KIS) + (size_t)b * LKS * 128, k_lo, k_hi, LKS,
                        (float*)(ws + OFF_SCORE_S) + (size_t)(b * 16 + 2 * w) * LKSP, LKSP, lane);
        } else {
            u -= 64; int g = 7; while (u >= 16 * (g + 1)) { u -= 16 * (g + 1); --g; }
            const int seg = u % (g + 1), rem = u / (g + 1), b = rem & 1, c = 8 * g + (rem >> 1);
            const int lvis = 64 * (c + 1), k_lo = seg * 512, k_hi = (k_lo + 512 < lvis) ? k_lo + 512 : lvis;
            if (k_lo < k_hi)
                idx_block(tid, lds, QI, WI, b * 4096 + c * 64 + 8 * w, (const bf16_t*)(ws + OFF_KIP) + (size_t)b * 4096 * 128, k_lo, k_hi,
                          (float*)(ws + OFF_SCORE) + (size_t)b * TRI + (size_t)4096 * (c * (c + 1) / 2) + (size_t)(8 * w) * lvis, lvis);
        }
    }
}

DI unsigned fkey(float f) { const unsigned u = __float_as_uint(f); return (u & 0x80000000u) ? ~u : (u | 0x80000000u); }
DI void topk_radix(const float* sc, int n, int nw, unsigned* mrow, LAS int* hist, int lane) {
    unsigned prefix = 0, pmask = 0; int kk = 256;
    for (int pass = 0; pass < 4; ++pass) {
        const int shift = 24 - 8 * pass;
        for (int i = lane; i < 256; i += 64) hist[i] = 0;
        __builtin_amdgcn_fence(__ATOMIC_ACQ_REL, "workgroup");
        for (int i = lane; i < n; i += 64) { const unsigned k = fkey(sc[i]); if ((k & pmask) == prefix) atomicAdd((int*)(hist + ((k >> shift) & 255u)), 1); }
        __builtin_amdgcn_fence(__ATOMIC_ACQ_REL, "workgroup");
        const int h0 = hist[4 * lane], h1 = hist[4 * lane + 1], h2 = hist[4 * lane + 2], h3 = hist[4 * lane + 3];
        const int s = h0 + h1 + h2 + h3; int incl = s;
#pragma unroll
        for (int d = 1; d < 64; d <<= 1) { const int o = __shfl_down(incl, d); if (lane + d < 64) incl += o; }
        int a = incl - s, found = -1, nk = 0;
        if (a < kk && kk <= a + h3) { found = 4 * lane + 3; nk = kk - a; } a += h3;
        if (found < 0 && a < kk && kk <= a + h2) { found = 4 * lane + 2; nk = kk - a; } a += h2;
        if (found < 0 && a < kk && kk <= a + h1) { found = 4 * lane + 1; nk = kk - a; } a += h1;
        if (found < 0 && a < kk && kk <= a + h0) { found = 4 * lane; nk = kk - a; }
        const unsigned long long bal = __ballot(found >= 0); const int src = bal ? (__ffsll((long long)bal) - 1) : 0;
        found = __shfl(found, src); kk = __shfl(nk, src);
        prefix |= ((unsigned)found) << shift; pmask |= 255u << shift;
        __builtin_amdgcn_fence(__ATOMIC_ACQ_REL, "workgroup");
    }
    int eqbase = 0;
    for (int i0 = 0; i0 < n; i0 += 64) {
        const int i = i0 + lane; const bool in = i < n; const unsigned k = in ? fkey(sc[i]) : 0u;
        const bool gt = in && k > prefix, eq = in && k == prefix;
        const unsigned long long be = __ballot(eq); const int rank = eqbase + __popcll(be & ((1ull << lane) - 1ull));
        const bool sel = gt || (eq && rank < kk); eqbase += __popcll(be);
        const unsigned long long bs = __ballot(sel);
        if (lane == 0) { mrow[i0 >> 5] = (unsigned)bs; if ((i0 >> 5) + 1 < nw) mrow[(i0 >> 5) + 1] = (unsigned)(bs >> 32); }
    }
}
DI void phase_topk(const Params& p, const int tid, unsigned char* ws, LAS unsigned char* lds) {
    const int lane = tid & 63, w = __builtin_amdgcn_readfirstlane(tid >> 6), wv = blockIdx.x * 8 + w, nwv = gridDim.x * 8;
    constexpr int NCAND = 512;
    LAS int* hist = (LAS int*)(lds + w * 8192);
    LAS unsigned* ckey = (LAS unsigned*)(lds + w * 8192 + 1024);
    LAS int* cidx = (LAS int*)(lds + w * 8192 + 1024 + 2048);
    LAS unsigned* mk = (LAS unsigned*)(lds + w * 8192 + 1024 + 4096);
    for (int r = wv; r < MR; r += nwv) {
        const float* sc; int n;
        if (r < MPR) { const int b = r >> 12, t = r & 4095, c = t >> 6; n = 64 * (c + 1); sc = (const float*)(ws + OFF_SCORE) + (size_t)b * TRI + (size_t)4096 * (c * (c + 1) / 2) + (size_t)(t & 63) * n; }
        else { n = LKS; sc = (const float*)(ws + OFF_SCORE_S) + (size_t)(r - MPR) * LKSP; }
        unsigned* mrow = (unsigned*)(ws + OFF_MASK) + (size_t)r * 128;
        const int nw = (n + 31) >> 5;
        if (n <= 256) { for (int i = lane; i < nw; i += 64) { const int rem = n - 32 * i; mrow[i] = rem >= 32 ? 0xffffffffu : ((1u << rem) - 1u); } continue; }
        f32x4 v[16]; float mn = INFINITY, mx = -INFINITY;
#pragma unroll
        for (int j = 0; j < 16; ++j) { const int base = (j * 64 + lane) * 4; v[j] = (f32x4){-INFINITY, -INFINITY, -INFINITY, -INFINITY}; if (base < n) v[j] = *(const f32x4*)(sc + base); }
#pragma unroll
        for (int j = 0; j < 16; ++j) { const bool ok = (j * 64 + lane) * 4 < n;
#pragma unroll
            for (int e = 0; e < 4; ++e) { mx = fmaxf(mx, v[j][e]); mn = fminf(mn, ok ? v[j][e] : INFINITY); } }
#pragma unroll
        for (int d = 1; d < 64; d <<= 1) { mn = fminf(mn, __shfl_xor(mn, d)); mx = fmaxf(mx, __shfl_xor(mx, d)); }
        const float scale = (mx > mn) ? 255.0f / (mx - mn) : 0.f;
        for (int i = lane; i < 256; i += 64) hist[i] = 0;
        if (lane == 0) mk[128] = 0u;
        __builtin_amdgcn_fence(__ATOMIC_ACQ_REL, "workgroup");
#pragma unroll
        for (int j = 0; j < 16; ++j) if ((j * 64 + lane) * 4 < n) {
#pragma unroll
            for (int e = 0; e < 4; ++e) { int bk = (int)((v[j][e] - mn) * scale); bk = bk > 255 ? 255 : (bk < 0 ? 0 : bk); atomicAdd((int*)(hist + bk), 1); } }
        __builtin_amdgcn_fence(__ATOMIC_ACQ_REL, "workgroup");
        const int h0 = hist[4 * lane], h1 = hist[4 * lane + 1], h2 = hist[4 * lane + 2], h3 = hist[4 * lane + 3];
        const int s = h0 + h1 + h2 + h3; int incl = s;
#pragma unroll
        for (int d = 1; d < 64; d <<= 1) { const int o = __shfl_down(incl, d); if (lane + d < 64) incl += o; }
        int a = incl - s, found = -1, nk = 0, hb = 0;
        if (a < 256 && 256 <= a + h3) { found = 4 * lane + 3; nk = 256 - a; hb = h3; } a += h3;
        if (found < 0 && a < 256 && 256 <= a + h2) { found = 4 * lane + 2; nk = 256 - a; hb = h2; } a += h2;
        if (found < 0 && a < 256 && 256 <= a + h1) { found = 4 * lane + 1; nk = 256 - a; hb = h1; } a += h1;
        if (found < 0 && a < 256 && 256 <= a + h0) { found = 4 * lane; nk = 256 - a; hb = h0; }
        const unsigned long long bal = __ballot(found >= 0); const int src = bal ? (__ffsll((long long)bal) - 1) : 0;
        const int B = __shfl(found, src); nk = __shfl(nk, src); hb = __shfl(hb, src);
        if (hb > NCAND) { __builtin_amdgcn_fence(__ATOMIC_ACQ_REL, "workgroup"); topk_radix(sc, n, nw, mrow, hist, lane); continue; }
#pragma unroll
        for (int j = 0; j < 16; ++j) {
            const int base = (j * 64 + lane) * 4; const bool ok = base < n; unsigned nib = 0;
#pragma unroll
            for (int e = 0; e < 4; ++e) { int bk = (int)((v[j][e] - mn) * scale); bk = bk > 255 ? 255 : (bk < 0 ? 0 : bk);
                if (ok && bk > B) nib |= 1u << e;
                if (ok && bk == B) { const unsigned pos = atomicAdd((unsigned*)(mk + 128), 1u); if (pos < (unsigned)NCAND) { ckey[pos] = fkey(v[j][e]); cidx[pos] = base + e; } } }
            unsigned wd = nib << (4 * (lane & 7));
            wd |= __shfl_xor(wd, 1); wd |= __shfl_xor(wd, 2); wd |= __shfl_xor(wd, 4);
            if ((lane & 7) == 0 && j * 8 + (lane >> 3) < 128) mk[j * 8 + (lane >> 3)] = wd;
        }
        __builtin_amdgcn_fence(__ATOMIC_ACQ_REL, "workgroup");
        const int ncand = hb;
        for (int i = lane; i < ncand; i += 64) {
            const unsigned ki = ckey[i]; const int ii = cidx[i]; int rank = 0;
            for (int j = 0; j < ncand; ++j) { const unsigned kj = ckey[j]; rank += (kj > ki || (kj == ki && cidx[j] < ii)) ? 1 : 0; }
            if (rank < nk) atomicOr((unsigned*)(mk + (ii >> 5)), 1u << (ii & 31));
        }
        __builtin_amdgcn_fence(__ATOMIC_ACQ_REL, "workgroup");
        for (int i = lane; i < nw; i += 64) mrow[i] = mk[i];
        __builtin_amdgcn_fence(__ATOMIC_ACQ_REL, "workgroup");
    }
}

template <int DQK, bool MASK>
DI void attn_wave(const double* T, int lane, const bf16_t* qrow, int qpos, const bf16_t* kbase, int ldk, const bf16_t* kpe,
                  const bf16_t* vt, int ldv, int nkeys, int kt_begin, int kt_end, const unsigned* mrow, float qscale, float& m_out, float& l_out, f32x4 (&acc)[8]) {
    constexpr int NS = DQK / 32;
    const int r = lane & 15, q = lane >> 4;
    bf16x8 qf[NS];
#pragma unroll
    for (int s = 0; s < 4; ++s) { float v[8]; unpack8(*(const u32x4*)(qrow + 32 * s + 8 * q), v);
#pragma unroll
        for (int e = 0; e < 8; ++e) v[e] *= qscale;
        const u32x4 pk = pack8(v); qf[s] = *(const bf16x8*)&pk; }
    if (DQK == 192) { float x1[8], x2[8]; unpack8(*(const u32x4*)(qrow + 128 + 8 * q), x1); unpack8(*(const u32x4*)(qrow + 160 + 8 * q), x2);
#pragma unroll
        for (int e = 0; e < 8; ++e) { float c, s; rope_cs(T, qpos, 8 * q + e, c, s); const float a = x1[e], b = x2[e]; x1[e] = (a * c - b * s) * qscale; x2[e] = (b * c + a * s) * qscale; }
        const u32x4 p1 = pack8(x1), p2 = pack8(x2); qf[NS - 2] = *(const bf16x8*)&p1; qf[NS - 1] = *(const bf16x8*)&p2; }
    float m = -INFINITY, l = 0.f;
#pragma unroll
    for (int i = 0; i < 8; ++i) acc[i] = (f32x4){0.f, 0.f, 0.f, 0.f};
#pragma unroll 1
    for (int kt = kt_begin; kt < kt_end; ++kt) {
        const int k0 = kt * 32;
        f32x4 s0 = (f32x4){0.f, 0.f, 0.f, 0.f}, s1 = (f32x4){0.f, 0.f, 0.f, 0.f};
#pragma unroll
        for (int t = 0; t < 2; ++t) { const int key = k0 + 8 * (r >> 2) + 4 * t + (r & 3); const bf16_t* kr = kbase + (size_t)key * ldk + 8 * q;
            bf16x8 kf[NS];
#pragma unroll
            for (int s = 0; s < 4; ++s) kf[s] = *(const bf16x8*)(kr + 32 * s);
            if (DQK == 192) { const bf16_t* k2 = kpe + (size_t)key * 64 + 8 * q; kf[NS - 2] = *(const bf16x8*)k2; kf[NS - 1] = *(const bf16x8*)(k2 + 32); }
#pragma unroll
            for (int s = 0; s < NS; ++s) { if (t == 0) s0 = __builtin_amdgcn_mfma_f32_16x16x32_bf16(kf[s], qf[s], s0, 0, 0, 0); else s1 = __builtin_amdgcn_mfma_f32_16x16x32_bf16(kf[s], qf[s], s1, 0, 0, 0); } }
        bf16x8 vf[8];
#pragma unroll
        for (int i = 0; i < 8; ++i) vf[i] = *(const bf16x8*)(vt + (size_t)(16 * i + r) * ldv + k0 + 8 * q);
        float sv[8] = {s0[0], s0[1], s0[2], s0[3], s1[0], s1[1], s1[2], s1[3]};
        unsigned bits = 0xffu;
        if (MASK) bits = (mrow[kt] >> (8 * q)) & 0xffu;
        if (k0 + 32 > nkeys) {
#pragma unroll
            for (int j = 0; j < 8; ++j) if (k0 + 8 * q + j >= nkeys) bits &= ~(1u << j); }
        float tm = -INFINITY;
#pragma unroll
        for (int j = 0; j < 8; ++j) { sv[j] = ((bits >> j) & 1u) ? sv[j] : -INFINITY; tm = fmaxf(tm, sv[j]); }
        tm = fmaxf(tm, __shfl_xor(tm, 16)); tm = fmaxf(tm, __shfl_xor(tm, 32));
        const float mn = fmaxf(m, tm), mu = (mn == -INFINITY) ? 0.f : mn;
        const float al = __builtin_amdgcn_exp2f(m - mu);
        m = mn;
        float pj[8], ps = 0.f;
#pragma unroll
        for (int j = 0; j < 8; ++j) { pj[j] = __builtin_amdgcn_exp2f(sv[j] - mu); ps += pj[j]; }
        l = l * al + ps;
#pragma unroll
        for (int i = 0; i < 8; ++i) acc[i] = acc[i] * al;
        const u32x4 pk = pack8(pj); const bf16x8 pf = *(const bf16x8*)&pk;
#pragma unroll
        for (int i = 0; i < 8; ++i) acc[i] = __builtin_amdgcn_mfma_f32_16x16x32_bf16(vf[i], pf, acc[i], 0, 0, 0);
        asm volatile("" ::: "memory");
    }
    m_out = m; l_out = l;
}
DI void sample_combine_store(const int tid, LAS unsigned char* lds, int w, float m, float l, f32x4 (&acc)[8], bf16_t* orow) {
    const int lane = tid & 63, q = lane >> 4;
    LAS float* st = (LAS float*)lds;
    if (w >= 4) { LAS float* p = st + (size_t)(w - 4) * 34 * 64 + lane; p[0] = m; p[64] = l;
#pragma unroll
        for (int i = 0; i < 8; ++i)
#pragma unroll
            for (int j = 0; j < 4; ++j) p[(2 + 4 * i + j) * 64] = acc[i][j]; }
    __syncthreads();
    if (w < 4) { const LAS float* p = st + (size_t)w * 34 * 64 + lane; const float m2 = p[0], l2 = p[64];
        const float M = fmaxf(m, m2), mu = (M == -INFINITY) ? 0.f : M, a1 = __builtin_amdgcn_exp2f(m - mu), a2 = __builtin_amdgcn_exp2f(m2 - mu);
        float lt = l * a1 + l2 * a2; lt += __shfl_xor(lt, 16); lt += __shfl_xor(lt, 32);
        const float inv = lt > 0.f ? 1.0f / lt : 0.f;
#pragma unroll
        for (int i = 0; i < 8; ++i) { f32x4 o;
#pragma unroll
            for (int j = 0; j < 4; ++j) o[j] = (acc[i][j] * a1 + p[(2 + 4 * i + j) * 64] * a2) * inv;
            u32x2 w2; w2.x = cvt_pk_bf16(o[0], o[1]); w2.y = cvt_pk_bf16(o[2], o[3]); *(u32x2*)(orow + 16 * i + 4 * q) = w2; } }
}
template <int DQK, bool MASK>
DI void attn_block(const double* T, const int tid, LAS unsigned char* lds, const bf16_t* const (&qrow)[2], const int (&qpos)[2], const unsigned* const (&mrow)[2], bf16_t* const (&orow)[2],
                   const bf16_t* kbase, int ldk, const bf16_t* kpe, const bf16_t* vt, int ldv, int ntile_blk, int ntile_w, float qscale) {
    constexpr int NS = DQK / 32, KROW = DQK * 2 + 16, KBYTES = 64 * KROW, VROW = 144, VBYTES = 128 * VROW, BUF = KBYTES + VBYTES;
    const int lane = tid & 63, r = lane & 15, q = lane >> 4;
    bf16x8 qf[2][NS];
#pragma unroll
    for (int g = 0; g < 2; ++g) {
#pragma unroll
        for (int s = 0; s < 4; ++s) { float v[8]; unpack8(*(const u32x4*)(qrow[g] + 32 * s + 8 * q), v);
#pragma unroll
            for (int e = 0; e < 8; ++e) v[e] *= qscale;
            const u32x4 pk = pack8(v); qf[g][s] = *(const bf16x8*)&pk; }
        if (DQK == 192) { float x1[8], x2[8]; unpack8(*(const u32x4*)(qrow[g] + 128 + 8 * q), x1); unpack8(*(const u32x4*)(qrow[g] + 160 + 8 * q), x2);
#pragma unroll
            for (int e = 0; e < 8; ++e) { float c, s; rope_cs(T, qpos[g], 8 * q + e, c, s); const float a = x1[e], b = x2[e]; x1[e] = (a * c - b * s) * qscale; x2[e] = (b * c + a * s) * qscale; }
            const u32x4 p1 = pack8(x1), p2 = pack8(x2); qf[g][NS - 2] = *(const bf16x8*)&p1; qf[g][NS - 1] = *(const bf16x8*)&p2; }
    }
    float m[2], l[2]; f32x4 acc[2][8];
#pragma unroll
    for (int g = 0; g < 2; ++g) { m[g] = -INFINITY; l[g] = 0.f;
#pragma unroll
        for (int i = 0; i < 8; ++i) acc[g][i] = (f32x4){0.f, 0.f, 0.f, 0.f}; }
    const int krow0 = tid >> 4, kc16 = tid & 15;
    const int prow = tid >> 3, pc = tid & 7;
    const int vrow0 = tid >> 3, vc = tid & 7;
    const bf16_t* gk = kbase + (size_t)krow0 * ldk + kc16 * 8;
    const bf16_t* gp = (DQK == 192) ? kpe + (size_t)prow * 64 + pc * 8 : nullptr;
    const bf16_t* gv = vt + (size_t)vrow0 * ldv + vc * 8;
    const int lk = krow0 * KROW + kc16 * 16, lp = prow * KROW + 256 + pc * 16, lv = KBYTES + vrow0 * VROW + vc * 16;
    u32x4 sk0, sk1, sp, sv0, sv1;
    sp = (u32x4){0u, 0u, 0u, 0u};
#define AB_ISSUE(kc) do { const size_t k0_ = (size_t)(kc) * 64; sk0 = *(const u32x4*)(gk + k0_ * ldk); sk1 = *(const u32x4*)(gk + (k0_ + 32) * ldk); \
        if (DQK == 192) sp = *(const u32x4*)(gp + k0_ * 64); sv0 = *(const u32x4*)(gv + k0_); sv1 = *(const u32x4*)(gv + (size_t)64 * ldv + k0_); } while (0)
    AB_ISSUE(0);
    u32x2 mnext[2] = {(u32x2){0u, 0u}, (u32x2){0u, 0u}};
    if (MASK) {
#pragma unroll
        for (int g = 0; g < 2; ++g) mnext[g] = *(const u32x2*)(mrow[g]);
    }
#pragma unroll 1
    for (int kc = 0; kc < ntile_blk; ++kc) {
        u32x2 mcur[2] = {mnext[0], mnext[1]};
        LAS unsigned char* buf = lds + (kc & 1) * BUF;
        *(LAS u32x4*)(buf + lk) = sk0; *(LAS u32x4*)(buf + lk + 32 * KROW) = sk1;
        if (DQK == 192) *(LAS u32x4*)(buf + lp) = sp;
        *(LAS u32x4*)(buf + lv) = sv0; *(LAS u32x4*)(buf + lv + 64 * VROW) = sv1;
        __syncthreads();
        if (kc + 1 < ntile_blk) { AB_ISSUE(kc + 1);
            if (MASK) {
#pragma unroll
                for (int g = 0; g < 2; ++g) mnext[g] = *(const u32x2*)(mrow[g] + 2 * (kc + 1)); } }
        if (kc < ntile_w) {
#pragma unroll 1
            for (int sub = 0; sub < 2; ++sub) {
                f32x4 s0[2], s1[2];
#pragma unroll
                for (int g = 0; g < 2; ++g) { s0[g] = (f32x4){0.f, 0.f, 0.f, 0.f}; s1[g] = (f32x4){0.f, 0.f, 0.f, 0.f}; }
#pragma unroll
                for (int t = 0; t < 2; ++t) {
                    const LAS unsigned char* kr = buf + (32 * sub + 8 * (r >> 2) + 4 * t + (r & 3)) * KROW + 16 * q;
                    bf16x8 kf[NS];
#pragma unroll
                    for (int s = 0; s < NS; ++s) kf[s] = *(const LAS bf16x8*)(kr + 64 * s);
#pragma unroll
                    for (int g = 0; g < 2; ++g)
#pragma unroll
                        for (int s = 0; s < NS; ++s) { if (t == 0) s0[g] = __builtin_amdgcn_mfma_f32_16x16x32_bf16(kf[s], qf[g][s], s0[g], 0, 0, 0); else s1[g] = __builtin_amdgcn_mfma_f32_16x16x32_bf16(kf[s], qf[g][s], s1[g], 0, 0, 0); }
                }
                bf16x8 vf[8];
#pragma unroll
                for (int i = 0; i < 8; ++i) vf[i] = *(const LAS bf16x8*)(buf + KBYTES + (16 * i + r) * VROW + 64 * sub + 16 * q);
                bf16x8 pf[2];
#pragma unroll
                for (int g = 0; g < 2; ++g) {
                    float sv[8] = {s0[g][0], s0[g][1], s0[g][2], s0[g][3], s1[g][0], s1[g][1], s1[g][2], s1[g][3]};
                    float tm = -INFINITY;
                    if (MASK) { const unsigned bits = ((sub ? mcur[g].y : mcur[g].x) >> (8 * q)) & 0xffu;
#pragma unroll
                        for (int j = 0; j < 8; ++j) sv[j] = ((bits >> j) & 1u) ? sv[j] : -INFINITY; }
#pragma unroll
                    for (int j = 0; j < 8; ++j) tm = fmaxf(tm, sv[j]);
                    if (__builtin_amdgcn_ballot_w64(tm > m[g] + 8.0f) != 0ull) {
                        tm = fmaxf(tm, __shfl_xor(tm, 16)); tm = fmaxf(tm, __shfl_xor(tm, 32));
                        const float mn = fmaxf(m[g], tm), mu = (mn == -INFINITY) ? 0.f : mn;
                        const float al = __builtin_amdgcn_exp2f(m[g] - mu);
                        m[g] = mn; l[g] *= al;
#pragma unroll
                        for (int i = 0; i < 8; ++i) acc[g][i] = acc[g][i] * al;
                    }
                    const float mu = (m[g] == -INFINITY) ? 0.f : m[g];
                    float pj[8], ps = 0.f;
#pragma unroll
                    for (int j = 0; j < 8; ++j) { pj[j] = __builtin_amdgcn_exp2f(sv[j] - mu); ps += pj[j]; }
                    l[g] += ps;
                    const u32x4 pk = pack8(pj); pf[g] = *(const bf16x8*)&pk;
                }
#pragma unroll
                for (int g = 0; g < 2; ++g)
#pragma unroll
                    for (int i = 0; i < 8; ++i) acc[g][i] = __builtin_amdgcn_mfma_f32_16x16x32_bf16(vf[i], pf[g], acc[g][i], 0, 0, 0);
            }
        }
    }
#undef AB_ISSUE
#pragma unroll
    for (int g = 0; g < 2; ++g) {
        float lt = l[g]; lt += __shfl_xor(lt, 16); lt += __shfl_xor(lt, 32);
        const float inv = lt > 0.f ? 1.0f / lt : 0.f;
#pragma unroll
        for (int i = 0; i < 8; ++i) { const f32x4 o = acc[g][i] * inv; u32x2 w2; w2.x = cvt_pk_bf16(o[0], o[1]); w2.y = cvt_pk_bf16(o[2], o[3]);
            *(u32x2*)(orow[g] + 16 * i + 4 * q) = w2; }
    }
}
constexpr float LOG2E = 1.4426950408889634f;
constexpr float QS_DSA = 0.08838834764831845f * LOG2E;
constexpr float QS_MLA = 0.07216878364870323f * LOG2E;

DI void phase_attn_a(const Params& p, const int tid, unsigned char* ws, LAS unsigned char* lds) {
    unsigned* ctr = &g_ctr[1 * 64]; volatile LAS int* slot = (volatile LAS int*)(lds + 131072);
    const int lane = tid & 63, w = __builtin_amdgcn_readfirstlane(tid >> 6), cl = lane & 15;
    bf16_t* QB = (bf16_t*)(ws + OFF_QB); const unsigned* MK = (const unsigned*)(ws + OFF_MASK);
    for (;;) {
        const int u = next_unit(tid, ctr, slot);
        if (u >= 64) break;
        {
            const int su = u & 31, b = su >> 2, g = su & 3, hd = 4 * g + (w & 3), half = w >> 2, kt0 = half ? 33 : 0, kt1 = half ? 65 : 33, token = MPR + b * 16 + cl;
            float m, l; f32x4 acc[8];
            if (u < 32) {
                attn_wave<128, true>(p.T, lane, QB + (size_t)token * 2048 + hd * 128, 0, (const bf16_t*)(ws + OFF_KBS) + (size_t)b * LKS * 512 + g * 128, 512, nullptr,
                                     (const bf16_t*)(ws + OFF_VBTS) + (size_t)(b * 4 + g) * 128 * LKSP, LKSP, LKS, kt0, kt1, MK + (size_t)token * 128, QS_DSA, m, l, acc);
                sample_combine_store(tid, lds, w, m, l, acc, QB + (size_t)token * 2048 + hd * 128);
            } else {
                attn_wave<192, false>(p.T, lane, (const bf16_t*)(ws + OFF_QSMLA) + (size_t)(b * 16 + cl) * 3072 + hd * 192, PAST + cl, (const bf16_t*)(ws + OFF_KNS) + (size_t)b * LKS * 2048 + hd * 128, 2048,
                                      (const bf16_t*)(ws + OFF_KPES) + (size_t)b * LKS * 64, (const bf16_t*)(ws + OFF_VTS) + (size_t)(b * 16 + hd) * 128 * LKSP, LKSP, LKS, kt0, kt1, nullptr, QS_MLA, m, l, acc);
                sample_combine_store(tid, lds, w, m, l, acc, (bf16_t*)(ws + OFF_QI) + (size_t)token * 2048 + hd * 128);
            }
        }
    }
    unsigned* ctr2 = &g_ctr[3 * 64];
    for (;;) {
        int u = next_unit(tid, ctr2, slot);
        if (u >= 512) break;
        {
            const int c = 63 - (u >> 3), b = (u >> 2) & 1, g = u & 3;
            const int head = 4 * g + (w >> 1);
            const bf16_t* qr[2]; int qp[2] = {0, 0}; const unsigned* mr[2]; bf16_t* orw[2];
#pragma unroll
            for (int gq = 0; gq < 2; ++gq) { const int token = b * 4096 + 64 * c + 32 * (w & 1) + 16 * gq + cl; qr[gq] = QB + (size_t)token * 2048 + head * 128; orw[gq] = QB + (size_t)token * 2048 + head * 128; mr[gq] = MK + (size_t)token * 128; }
            attn_block<128, true>(p.T, tid, lds, qr, qp, mr, orw, (const bf16_t*)(ws + OFF_KBP) + (size_t)b * 4096 * 512 + g * 128, 512, nullptr,
                                  (const bf16_t*)(ws + OFF_VBTP) + (size_t)(b * 4 + g) * 128 * 4096, 4096, c + 1, c + 1, QS_DSA);
        }
    }
}
DI void phase_attn_b(const Params& p, const int tid, unsigned char* ws, LAS unsigned char* lds, int rep) {
    unsigned* ctr = &g_ctr[2 * 64]; (void)rep; volatile LAS int* slot = (volatile LAS int*)(lds + 131072);
    const int lane = tid & 63, w = __builtin_amdgcn_readfirstlane(tid >> 6), cl = lane & 15;
    for (;;) {
        const int u = next_unit(tid, ctr, slot);
        if (u >= 512) break;
        const int qt = 15 - (u >> 5), b = (u >> 4) & 1, h = u & 15;
        const bf16_t* qr[2]; int qp[2]; const unsigned* mr[2] = {nullptr, nullptr}; bf16_t* orw[2];
#pragma unroll
        for (int gq = 0; gq < 2; ++gq) { const int t = 256 * qt + 32 * w + 16 * gq + cl, token = b * 4096 + t; qp[gq] = t;
            qr[gq] = (const bf16_t*)(ws + OFF_QMLA) + (size_t)token * 3072 + h * 192; orw[gq] = (bf16_t*)(ws + OFF_QI) + (size_t)token * 2048 + h * 128; }
        const int chunk = 4 * qt + (w >> 1);
        attn_block<192, false>(p.T, tid, lds, qr, qp, mr, orw, (const bf16_t*)(ws + OFF_KNP) + (size_t)b * 4096 * 2048 + h * 128, 2048, (const bf16_t*)(ws + OFF_KPEP) + (size_t)b * 4096 * 64,
                               (const bf16_t*)(ws + OFF_VTP) + (size_t)(b * 16 + h) * 128 * 4096, 4096, 4 * qt + 4, chunk + 1, QS_MLA);
    }
}

DI void phase_ln(const Params& p, const int tid, const float* src, const float* g, const float* bt, float* of32, bf16_t* obf, bool to_out, const float* sres, const float* part, int nsl) {
    const int lane = tid & 63, wv = blockIdx.x * 8 + __builtin_amdgcn_readfirstlane(tid >> 6), nwv = gridDim.x * 8;
    for (int r = wv; r < MR; r += nwv) {
        const float* s = src + (size_t)r * 2048; f32x4 v[8]; float sum = 0.f;
        if (r < MPR) {
#pragma unroll
            for (int i = 0; i < 8; ++i) v[i] = __builtin_nontemporal_load((const f32x4*)(s + 256 * i + 4 * lane));
        } else {
            const float* rs = sres + (size_t)(r - MPR) * 2048;
#pragma unroll
            for (int i = 0; i < 8; ++i) v[i] = *(const f32x4*)(rs + 256 * i + 4 * lane) * ALPHA;
            for (int sl0 = 0; sl0 < nsl; sl0 += 4) {
                f32x4 t[4][8];
#pragma unroll
                for (int k = 0; k < 4; ++k) { const float* pp = part + ((size_t)(sl0 + k) * 128 + (r - MPR)) * 2048;
#pragma unroll
                    for (int i = 0; i < 8; ++i) t[k][i] = *(const f32x4*)(pp + 256 * i + 4 * lane); }
#pragma unroll
                for (int k = 0; k < 4; ++k)
#pragma unroll
                    for (int i = 0; i < 8; ++i) v[i] = v[i] + t[k][i];
            }
        }
#pragma unroll
        for (int i = 0; i < 8; ++i) sum += v[i].x + v[i].y + v[i].z + v[i].w;
#pragma unroll
        for (int d = 1; d < 64; d <<= 1) sum += __shfl_xor(sum, d);
        const float mu = sum * (1.0f / 2048.0f); float sq = 0.f;
#pragma unroll
        for (int i = 0; i < 8; ++i) { v[i] = v[i] - mu; sq += v[i].x * v[i].x + v[i].y * v[i].y + v[i].z * v[i].z + v[i].w * v[i].w; }
#pragma unroll
        for (int d = 1; d < 64; d <<= 1) sq += __shfl_xor(sq, d);
        const float rstd = rsqrtf(sq * (1.0f / 2048.0f) + NORM_EPS);
        float* o = to_out ? (p.out + (r < MPR ? OUT_YP + (size_t)r * 2048 : OUT_YS + (size_t)(r - MPR) * 2048)) : of32 + (size_t)r * 2048;
#pragma unroll
        for (int i = 0; i < 8; ++i) { const int c = 256 * i + 4 * lane; const f32x4 y = v[i] * rstd * *(const f32x4*)(g + c) + *(const f32x4*)(bt + c);
            if (to_out) __builtin_nontemporal_store(y, (f32x4*)(o + c)); else *(f32x4*)(o + c) = y;
            if (obf) { u32x2 w2; w2.x = cvt_pk_bf16(y.x, y.y); w2.y = cvt_pk_bf16(y.z, y.w); *(u32x2*)(obf + (size_t)r * 2048 + c) = w2; } }
    }
}

DI void phase_fin_merged(const int tid, unsigned char* ws) {
    const size_t gtid = (size_t)blockIdx.x * NTHREADS + tid, gsz = (size_t)gridDim.x * NTHREADS;
    const float* P = (const float*)(ws + OFF_PART);
    for (size_t i = gtid; i < (size_t)MS * 512; i += gsz) {
        const int r = (int)(i >> 9), c = (int)(i & 511) * 4;
        f32x4 a = (f32x4){0.f, 0.f, 0.f, 0.f}, b = a;
        for (int sl = 0; sl < 8; ++sl) { a = a + *(const f32x4*)(P + ((size_t)sl * 128 + r) * 2048 + c); b = b + *(const f32x4*)(P + ((size_t)(sl + 8) * 128 + r) * 2048 + c); }
        const bf16_t* g = (const bf16_t*)(ws + OFF_GATES) + (size_t)(MPR + r) * 4096 + c;
        const u32x2 ga = *(const u32x2*)g, gb = *(const u32x2*)(g + 2048);
        const float o0 = sigmoidf(bflo(ga.x)) * a[0] + sigmoidf(bflo(gb.x)) * b[0], o1 = sigmoidf(bfhi(ga.x)) * a[1] + sigmoidf(bfhi(gb.x)) * b[1];
        const float o2 = sigmoidf(bflo(ga.y)) * a[2] + sigmoidf(bflo(gb.y)) * b[2], o3 = sigmoidf(bfhi(ga.y)) * a[3] + sigmoidf(bfhi(gb.y)) * b[3];
        u32x2 w2; w2.x = cvt_pk_bf16(o0, o1); w2.y = cvt_pk_bf16(o2, o3);
        *(u32x2*)((bf16_t*)(ws + OFF_MERGED) + (size_t)(MPR + r) * 2048 + c) = w2;
    }
}
DI void phase_fin_u(const int tid, unsigned char* ws) {
    const size_t gtid = (size_t)blockIdx.x * NTHREADS + tid, gsz = (size_t)gridDim.x * NTHREADS;
    const float* P = (const float*)(ws + OFF_PART);
    for (size_t i = gtid; i < (size_t)MS * 2048; i += gsz) {
        const int r = (int)(i >> 11), c = (int)(i & 2047) * 4;
        f32x4 a = (f32x4){0.f, 0.f, 0.f, 0.f};
        for (int sl = 0; sl < 8; ++sl) a = a + *(const f32x4*)(P + ((size_t)sl * 128 + r) * 8192 + c);
        float t0 = fmaxf(a[0], 0.f), t1 = fmaxf(a[1], 0.f), t2 = fmaxf(a[2], 0.f), t3 = fmaxf(a[3], 0.f);
        u32x2 w2; w2.x = cvt_pk_bf16(t0 * t0, t1 * t1); w2.y = cvt_pk_bf16(t2 * t2, t3 * t3);
        *(u32x2*)((bf16_t*)(ws + OFF_U) + (size_t)(MPR + r) * 8192 + c) = w2;
    }
}

__device__ unsigned g_bar[64 * 10];
DI unsigned xb_ld(unsigned* p) { return __hip_atomic_load(p, __ATOMIC_RELAXED, __HIP_MEMORY_SCOPE_AGENT); }
DI unsigned xb_add(unsigned* p, unsigned v) { return __hip_atomic_fetch_add(p, v, __ATOMIC_RELAXED, __HIP_MEMORY_SCOPE_AGENT); }
DI void fast_barrier() {
    asm volatile("s_waitcnt vmcnt(0)" ::: "memory");
    __syncthreads();
    if (threadIdx.x == 0) {
        __builtin_amdgcn_fence(__ATOMIC_RELEASE, "agent");
        asm volatile("s_waitcnt vmcnt(0)" ::: "memory");
        const unsigned gen0 = xb_ld(&g_bar[9 * 64]);
        const unsigned G = gridDim.x, g = blockIdx.x >> 5, ng = (G + 31u) >> 5, nin = (G - 32u * g) < 32u ? (G - 32u * g) : 32u;
        const unsigned old = xb_add(&g_bar[g * 64], 1u);
        if (old + 1u == nin) {
            xb_add(&g_bar[g * 64], 0u - nin);
            const unsigned ot = xb_add(&g_bar[8 * 64], 1u);
            if (ot + 1u == ng) { xb_add(&g_bar[8 * 64], 0u - ng); xb_add(&g_bar[9 * 64], 1u); }
        }
        unsigned sp = 0;
        while (xb_ld(&g_bar[9 * 64]) == gen0) { __builtin_amdgcn_s_sleep(1); if (++sp > (1u << 22)) break; }
        __builtin_amdgcn_fence(__ATOMIC_ACQUIRE, "agent");
        asm volatile("s_waitcnt vmcnt(0)" ::: "memory");
    }
    __syncthreads();
}

constexpr int NPHASE = 17;
__global__ void __launch_bounds__(NTHREADS, 2) mega(Params p) {
    extern __shared__ __attribute__((aligned(16))) unsigned char lds_raw[];
    LAS unsigned char* lds = (LAS unsigned char*)lds_raw;
    cg::grid_group grid = cg::this_grid();
#ifndef DUP_PHASE
#define DUP_PHASE -1
#endif
#ifndef PH_MASK
#define PH_MASK 0x1ffff
#endif
#define RUN_PHASE(n, rep_, ...) if (p.ph_lo <= (n) && (n) < p.ph_hi && (PH_MASK & (1 << (n)))) { if ((n) > p.ph_lo || (rep_)) { if ((n) == 1 && !(rep_)) grid.sync(); else fast_barrier(); } const int rep = (rep_); (void)rep; \
        unsigned wl_ = (unsigned)(unsigned long long)p.ws, wh_ = (unsigned)((unsigned long long)p.ws >> 32); asm volatile("" : "+v"(wl_), "+v"(wh_)); unsigned char* ws = (unsigned char*)(((unsigned long long)(unsigned)__builtin_amdgcn_readfirstlane(wh_) << 32) | (unsigned)__builtin_amdgcn_readfirstlane(wl_)); int tid = threadIdx.x; asm volatile("" : "+v"(tid)); __VA_ARGS__ }
    RUN_PHASE(0, 0, phase_prep(p, tid, ws, lds);)
#if DUP_PHASE == 0
    RUN_PHASE(0, 1, phase_prep(p, tid, ws, lds);)
#endif
    RUN_PHASE(1, 0, { pg8::Sched S; S.init1(2048, (const bf16_t*)(ws + OFF_XB), (const bf16_t*)(ws + OFF_WINT), 33, 41); EpiB E{EM_PROJ, ws, 2048}; pg8::gemm_phase(tid, lds, 2048, S, E); })
#if DUP_PHASE == 1
    RUN_PHASE(1, 1, { pg8::Sched S; S.init1(2048, (const bf16_t*)(ws + OFF_XB), (const bf16_t*)(ws + OFF_WINT), 33, 41); EpiB E{EM_PROJ, ws, 2048}; pg8::gemm_phase(tid, lds, 2048, S, E); })
#endif
    RUN_PHASE(2, 0, phase_post(p, tid, ws, lds);)
#if DUP_PHASE == 2
    RUN_PHASE(2, 1, phase_post(p, tid, ws, lds);)
#endif
    RUN_PHASE(3, 0, phase_index(p, tid, ws, lds, rep);)
#if DUP_PHASE == 3
    RUN_PHASE(3, 1, phase_index(p, tid, ws, lds, rep);)
#endif
    RUN_PHASE(4, 0, { if (blockIdx.x == 0 && tid == 0) __hip_atomic_store(&g_ctr[0 * 64], 0u, __ATOMIC_RELAXED, __HIP_MEMORY_SCOPE_AGENT); phase_topk(p, tid, ws, lds); })
#if DUP_PHASE == 4
    RUN_PHASE(4, 1, phase_topk(p, tid, ws, lds);)
#endif
    RUN_PHASE(5, 0, { pg8::Sched S; S.init3(512, (const bf16_t*)(ws + OFF_QLN) + (size_t)MPR * 512, (const bf16_t*)(ws + OFF_WUQT), 1, 12,
                                         (const bf16_t*)(ws + OFF_CKVS), (const bf16_t*)(ws + OFF_WUKT), 65, 8,
                                         (const bf16_t*)(ws + OFF_WUVT), (const bf16_t*)(ws + OFF_CKVS), 8, 65);
                  EpiB E{EM_UPS, ws, 2048}; pg8::gemm_phase(tid, lds, 512, S, E); })
#if DUP_PHASE == 5
    RUN_PHASE(5, 1, { pg8::Sched S; S.init3(512, (const bf16_t*)(ws + OFF_QLN) + (size_t)MPR * 512, (const bf16_t*)(ws + OFF_WUQT), 1, 12,
                                         (const bf16_t*)(ws + OFF_CKVS), (const bf16_t*)(ws + OFF_WUKT), 65, 8,
                                         (const bf16_t*)(ws + OFF_WUVT), (const bf16_t*)(ws + OFF_CKVS), 8, 65);
                  EpiB E{EM_UPS, ws, 2048}; pg8::gemm_phase(tid, lds, 512, S, E); })
#endif
    RUN_PHASE(6, 0, phase_attn_a(p, tid, ws, lds);)
#if DUP_PHASE == 6
    RUN_PHASE(6, 1, phase_attn_a(p, tid, ws, lds);)
#endif
    RUN_PHASE(7, 0, { if (blockIdx.x == 0 && tid == 0) { __hip_atomic_store(&g_ctr[1 * 64], 0u, __ATOMIC_RELAXED, __HIP_MEMORY_SCOPE_AGENT); __hip_atomic_store(&g_ctr[3 * 64], 0u, __ATOMIC_RELAXED, __HIP_MEMORY_SCOPE_AGENT); } pg8::Sched S; S.init3(512, (const bf16_t*)(ws + OFF_QLN), (const bf16_t*)(ws + OFF_WUQT), 32, 12,
                                         (const bf16_t*)(ws + OFF_CKVP), (const bf16_t*)(ws + OFF_WUKT), 32, 8,
                                         (const bf16_t*)(ws + OFF_WUVT), (const bf16_t*)(ws + OFF_CKVP), 8, 32);
                  EpiB E{EM_UPP, ws, 2048}; pg8::gemm_phase(tid, lds, 512, S, E); })
#if DUP_PHASE == 7
    RUN_PHASE(7, 1, { pg8::Sched S; S.init3(512, (const bf16_t*)(ws + OFF_QLN), (const bf16_t*)(ws + OFF_WUQT), 32, 12,
                                         (const bf16_t*)(ws + OFF_CKVP), (const bf16_t*)(ws + OFF_WUKT), 32, 8,
                                         (const bf16_t*)(ws + OFF_WUVT), (const bf16_t*)(ws + OFF_CKVP), 8, 32);
                  EpiB E{EM_UPP, ws, 2048}; pg8::gemm_phase(tid, lds, 512, S, E); })
#endif
    RUN_PHASE(8, 0, phase_attn_b(p, tid, ws, lds, rep);)
#if DUP_PHASE == 8
    RUN_PHASE(8, 1, phase_attn_b(p, tid, ws, lds, rep);)
#endif
    RUN_PHASE(9, 0, { if (blockIdx.x == 0 && tid == 0) __hip_atomic_store(&g_ctr[2 * 64], 0u, __ATOMIC_RELAXED, __HIP_MEMORY_SCOPE_AGENT); pg8::Sched S; S.init1(2048, (const bf16_t*)(ws + OFF_QI), (const bf16_t*)(ws + OFF_WO), 32, 8); S.add_second((const bf16_t*)(ws + OFF_QB), (const bf16_t*)(ws + OFF_WO) + (size_t)2048 * 2048, 32);
                  S.add_split((const bf16_t*)(ws + OFF_QI) + (size_t)MPR * 2048, (const bf16_t*)(ws + OFF_WO), 8, 16, 256); S.split_second((const bf16_t*)(ws + OFF_QB) + (size_t)MPR * 2048, (const bf16_t*)(ws + OFF_WO) + (size_t)2048 * 2048, 8);
                  EpiB E{EM_OF, ws, 2048}; pg8::gemm_phase(tid, lds, 2048, S, E); })
#if DUP_PHASE == 9
    RUN_PHASE(9, 1, { pg8::Sched S; S.init1(2048, (const bf16_t*)(ws + OFF_QI), (const bf16_t*)(ws + OFF_WO), 32, 8); S.add_second((const bf16_t*)(ws + OFF_QB), (const bf16_t*)(ws + OFF_WO) + (size_t)2048 * 2048, 32);
                  S.add_split((const bf16_t*)(ws + OFF_QI) + (size_t)MPR * 2048, (const bf16_t*)(ws + OFF_WO), 8, 16, 256); S.split_second((const bf16_t*)(ws + OFF_QB) + (size_t)MPR * 2048, (const bf16_t*)(ws + OFF_WO) + (size_t)2048 * 2048, 8);
                  EpiB E{EM_OF, ws, 2048}; pg8::gemm_phase(tid, lds, 2048, S, E); })
#endif
    RUN_PHASE(15, 0, phase_fin_merged(tid, ws);)
    RUN_PHASE(10, 0, { pg8::Sched S; S.init1(2048, (const bf16_t*)(ws + OFF_MERGED), (const bf16_t*)(ws + OFF_WO) + (size_t)2 * 2048 * 2048, 32, 8);
                   S.add_split((const bf16_t*)(ws + OFF_MERGED) + (size_t)MPR * 2048, (const bf16_t*)(ws + OFF_WO) + (size_t)2 * 2048 * 2048, 8, 8, 256);
                   EpiF E{EF_OUT, ws, p.x_prompt, p.x_sample}; pg8::gemm_phase(tid, lds, 2048, S, E); })
#if DUP_PHASE == 10
    RUN_PHASE(10, 1, { pg8::Sched S; S.init1(2048, (const bf16_t*)(ws + OFF_MERGED), (const bf16_t*)(ws + OFF_WO) + (size_t)2 * 2048 * 2048, 32, 8);
                   S.add_split((const bf16_t*)(ws + OFF_MERGED) + (size_t)MPR * 2048, (const bf16_t*)(ws + OFF_WO) + (size_t)2 * 2048 * 2048, 8, 8, 256);
                   EpiF E{EF_OUT, ws, p.x_prompt, p.x_sample}; pg8::gemm_phase(tid, lds, 2048, S, E); })
#endif
    RUN_PHASE(11, 0, { phase_ln(p, tid, (const float*)(ws + OFF_R1), p.ln1_g, p.ln1_b, (float*)(ws + OFF_H), (bf16_t*)(ws + OFF_HB), false, p.x_sample, (const float*)(ws + OFF_PART), 8);
                   const size_t gtid = (size_t)blockIdx.x * NTHREADS + tid, gsz = (size_t)gridDim.x * NTHREADS;
                   for (size_t i = gtid; i < (size_t)(MPAD - MR) * 256; i += gsz) *(u32x4*)((bf16_t*)(ws + OFF_HB) + (size_t)MR * 2048 + i * 8) = (u32x4){0u, 0u, 0u, 0u};
                   transpose_jobs(p, tid, lds, NTJ - 2, NTJ, blockIdx.x, gridDim.x); })
#if DUP_PHASE == 11
    RUN_PHASE(11, 1, { phase_ln(p, tid, (const float*)(ws + OFF_R1), p.ln1_g, p.ln1_b, (float*)(ws + OFF_H), (bf16_t*)(ws + OFF_HB), false, p.x_sample, (const float*)(ws + OFF_PART), 8);
                   const size_t gtid = (size_t)blockIdx.x * NTHREADS + tid, gsz = (size_t)gridDim.x * NTHREADS;
                   for (size_t i = gtid; i < (size_t)(MPAD - MR) * 256; i += gsz) *(u32x4*)((bf16_t*)(ws + OFF_HB) + (size_t)MR * 2048 + i * 8) = (u32x4){0u, 0u, 0u, 0u};
                   transpose_jobs(p, tid, lds, NTJ - 2, NTJ, blockIdx.x, gridDim.x); })
#endif
    RUN_PHASE(12, 0, { pg8::Sched S; S.init1(2048, (const bf16_t*)(ws + OFF_HB), (const bf16_t*)(ws + OFF_WUPT), 32, 32); S.add_split((const bf16_t*)(ws + OFF_HB) + (size_t)MPR * 2048, (const bf16_t*)(ws + OFF_WUPT), 32, 8, 256); EpiB E{EM_FFNUP, ws, 8192}; pg8::gemm_phase(tid, lds, 2048, S, E); })
#if DUP_PHASE == 12
    RUN_PHASE(12, 1, { pg8::Sched S; S.init1(2048, (const bf16_t*)(ws + OFF_HB), (const bf16_t*)(ws + OFF_WUPT), 32, 32); S.add_split((const bf16_t*)(ws + OFF_HB) + (size_t)MPR * 2048, (const bf16_t*)(ws + OFF_WUPT), 32, 8, 256); EpiB E{EM_FFNUP, ws, 8192}; pg8::gemm_phase(tid, lds, 2048, S, E); })
#endif
    RUN_PHASE(16, 0, phase_fin_u(tid, ws);)
    RUN_PHASE(13, 0, { pg8::Sched S; S.init1(8192, (const bf16_t*)(ws + OFF_U), (const bf16_t*)(ws + OFF_WDNT), 32, 8); S.add_split((const bf16_t*)(ws + OFF_U) + (size_t)MPR * 8192, (const bf16_t*)(ws + OFF_WDNT), 8, 8, 1024); EpiF E{EF_DOWN, ws, p.x_prompt, p.x_sample}; pg8::gemm_phase(tid, lds, 8192, S, E); })
#if DUP_PHASE == 13
    RUN_PHASE(13, 1, { pg8::Sched S; S.init1(8192, (const bf16_t*)(ws + OFF_U), (const bf16_t*)(ws + OFF_WDNT), 32, 8); S.add_split((const bf16_t*)(ws + OFF_U) + (size_t)MPR * 8192, (const bf16_t*)(ws + OFF_WDNT), 8, 8, 1024); EpiF E{EF_DOWN, ws, p.x_prompt, p.x_sample}; pg8::gemm_phase(tid, lds, 8192, S, E); })
#endif
    RUN_PHASE(14, 0, phase_ln(p, tid, (const float*)(ws + OFF_R1), p.ln2_g, p.ln2_b, nullptr, nullptr, true, (const float*)(ws + OFF_H) + (size_t)MPR * 2048, (const float*)(ws + OFF_PART), 8);)
#if DUP_PHASE == 14
    RUN_PHASE(14, 1, phase_ln(p, tid, (const float*)(ws + OFF_R1), p.ln2_g, p.ln2_b, nullptr, nullptr, true, (const float*)(ws + OFF_H) + (size_t)MPR * 2048, (const float*)(ws + OFF_PART), 8);)
#endif
#undef RUN_PHASE
}

static void add_tjob(Params& P, int& nj, const float* src, bf16_t* dst, int K, int ld, int c0, int ncols, int segw, int segs, int dld) {
    TJob& j = P.tj[nj]; j.src = src; j.dst = dst; j.K = K; j.ld = ld; j.c0 = c0; j.ncols = ncols; j.segw = segw; j.segs = segs; j.dld = dld; j.pad = 0;
    P.tfirst[nj + 1] = P.tfirst[nj] + (K / 64) * ((ncols + 63) / 64); ++nj;
}
extern "C" void kernel_launch(void* const* d_in, const int* in_sizes, int n_in, void* d_out, int out_size, void* d_ws, size_t ws_size, hipStream_t stream) {
    static int grid = 0;
    if (grid == 0) {
        if (n_in != 21 || ws_size < WS_NEED) { fprintf(stderr, "kernel_launch: bad inputs (n_in %d, ws %zu need %zu)\n", n_in, ws_size, (size_t)WS_NEED); grid = -1; return; }
        int dev = 0, cus = 0, per_cu = 0;
        hipGetDevice(&dev); hipDeviceGetAttribute(&cus, hipDeviceAttributeMultiprocessorCount, dev);
        if (hipFuncSetAttribute((const void*)mega, hipFuncAttributeMaxDynamicSharedMemorySize, LDS_BYTES) != hipSuccess) { fprintf(stderr, "kernel_launch: hipFuncSetAttribute failed\n"); grid = -1; return; }
        if (hipOccupancyMaxActiveBlocksPerMultiprocessor(&per_cu, (const void*)mega, NTHREADS, LDS_BYTES) != hipSuccess || per_cu < 1) { fprintf(stderr, "kernel_launch: occupancy query failed (%d)\n", per_cu); (void)hipGetLastError(); per_cu = 1; }
        grid = cus * per_cu;
    }
    if (grid < 0) return;
    Params P{};
    const float** ip = &P.x_prompt;
    for (int i = 0; i < 21; ++i) ip[i] = (const float*)d_in[i];
    P.out = (float*)d_out; P.ws = (unsigned char*)d_ws;
    for (int i = 0; i < 32; ++i) P.T[i] = pow(500000.0, -(double)i / 32.0);
    unsigned char* ws = (unsigned char*)d_ws;
    int nj = 0; P.tfirst[0] = 0;
    {
        bf16_t* wt = (bf16_t*)(ws + OFF_WINT);
        const int seg[11][3] = {{1088, 2048, 0}, {4160, 2048, 2048}, {6352, 2048, 4096}, {8400, 2048, 6144}, {0, 512, 8192}, {512, 512, 8704}, {3136, 512, 9216}, {3648, 512, 9728},
                                {1024, 64, 10240}, {6208, 128, 10304}, {6336, 16, 10432}};
        for (int s = 0; s < 11; ++s) add_tjob(P, nj, P.w_in, wt + (size_t)seg[s][2] * 2048, 2048, 10448, seg[s][0], seg[s][1], 1 << 30, 0, 2048);
    }
    add_tjob(P, nj, P.w_uq, (bf16_t*)(ws + OFF_WUQT), 512, 3072, 0, 3072, 1 << 30, 0, 512);
    add_tjob(P, nj, P.w_ukv, (bf16_t*)(ws + OFF_WUKT), 512, 4096, 0, 2048, 128, 256, 512);
    add_tjob(P, nj, P.w_ukv, (bf16_t*)(ws + OFF_WUVT), 512, 4096, 128, 2048, 128, 256, 512);
    add_tjob(P, nj, P.w_o_mla, (bf16_t*)(ws + OFF_WO), 2048, 2048, 0, 2048, 1 << 30, 0, 2048);
    add_tjob(P, nj, P.w_o_dsa, (bf16_t*)(ws + OFF_WO) + (size_t)2048 * 2048, 2048, 2048, 0, 2048, 1 << 30, 0, 2048);
    add_tjob(P, nj, P.w_out, (bf16_t*)(ws + OFF_WO) + (size_t)2 * 2048 * 2048, 2048, 2048, 0, 2048, 1 << 30, 0, 2048);
    for (int b = 0; b < 8; ++b) add_tjob(P, nj, P.c_v + (size_t)b * PAST * 512, (bf16_t*)(ws + OFF_VBTS) + (size_t)b * 512 * LKSP, PAST, 512, 0, 512, 1 << 30, 0, LKSP);
    add_tjob(P, nj, P.w_up, (bf16_t*)(ws + OFF_WUPT), 2048, 8192, 0, 8192, 1 << 30, 0, 2048);
    add_tjob(P, nj, P.w_down, (bf16_t*)(ws + OFF_WDNT), 8192, 2048, 0, 2048, 1 << 30, 0, 8192);
    if (nj != NTJ) { fprintf(stderr, "kernel_launch: job count %d\n", nj); return; }
#if ONE_LAUNCH
    P.ph_lo = 0; P.ph_hi = NPHASE;
    void* args[] = {&P};
    hipError_t e = hipLaunchCooperativeKernel((const void*)mega, dim3(grid), dim3(NTHREADS), args, LDS_BYTES, stream);
    if (e != hipSuccess) fprintf(stderr, "cooperative launch failed: %s (grid %d)\n", hipGetErrorString(e), grid);
#else
    const int order[NPHASE] = {0, 1, 2, 3, 4, 5, 6, 7, 8, 9, 15, 10, 11, 12, 16, 13, 14};
    for (int oi = 0; oi < NPHASE; ++oi) {
        const int ph = order[oi]; P.ph_lo = ph; P.ph_hi = ph + 1;
        void* args[] = {&P};
        hipError_t e = hipLaunchCooperativeKernel((const void*)mega, dim3(grid), dim3(NTHREADS), args, LDS_BYTES, stream);
        if (e != hipSuccess) fprintf(stderr, "launch %d failed: %s (grid %d)\n", ph, hipGetErrorString(e), grid);
    }
#endif
}
```
